# Optimizing an MI355X kernel written in HIP

```python
import jax, jax.numpy as jnp
from jax import lax
import numpy as np

D_MODEL = 1024
BATCH = 8
SEQ = 2048
DEPTH = 2

CTX_LEN = 256
GRID_W = 64
N_MIXERS = 2
HGRN_HEADS = 8
HGRN_HEAD_DIM = D_MODEL // HGRN_HEADS
HGRN_WIDTH = HGRN_HEADS * HGRN_HEAD_DIM
CHUNK = 64
POOL_WINDOWS = (2, 4, 8, 16)
POOL_WIDTH = D_MODEL
POOL_GROUPS = len(POOL_WINDOWS)
POOL_GROUP_DIM = POOL_WIDTH // POOL_GROUPS
N_HGRN_LAYERS = (DEPTH + 1) // 2
N_POOL_LAYERS = DEPTH // 2
EPS = 1e-6

kernel_name = 'hybrid_hgrn2_pool_prefix_dit'


def rmsnorm(x, w):
    xf = x.astype(jnp.float32)
    y = xf * lax.rsqrt(jnp.mean(xf * xf, axis=-1, keepdims=True) + EPS)
    return (y * w.astype(jnp.float32)).astype(x.dtype)


def _adaln(cond, w, b):
    mod = jax.nn.silu(cond) @ w + b
    return jnp.split(mod[:, None, :], 3, axis=-1)


def lower_bounds(logits):
    lg = jnp.concatenate([logits, jnp.zeros_like(logits[:1])], axis=0).astype(jnp.float32)
    p = jax.nn.softmax(lg, axis=0)
    return jnp.cumsum(p, axis=0)[: logits.shape[0]]


def _heads(a):
    b, t, _ = a.shape
    return a.reshape(b, t, HGRN_HEADS, HGRN_HEAD_DIM).transpose(0, 2, 1, 3)


def _chunk(a):
    b, h, t, d = a.shape
    return a.reshape(b, h, t // CHUNK, CHUNK, d)


def _inter_chunk_states(k_c, v_c, b_c, s0):
    b_last = b_c[:, :, :, -1]
    k_end = k_c * jnp.exp(b_last[:, :, :, None, :] - b_c)
    u = jnp.einsum('bhnck,bhncv->bhnkv', k_end, v_c)
    decay = jnp.exp(b_last)

    def step(s, inp):
        d_n, u_n = inp
        return d_n[..., None] * s + u_n, s

    s_final, s_prev = lax.scan(step, s0, (jnp.moveaxis(decay, 2, 0), jnp.moveaxis(u, 2, 0)))
    return jnp.moveaxis(s_prev, 0, 2), s_final


def gla_forward(q, k, v, log_f, s0):
    b, h, t, _ = q.shape
    q_c, k_c, v_c = _chunk(q), _chunk(k), _chunk(v)
    b_c = jnp.cumsum(_chunk(log_f), axis=3)
    s_prev, _ = _inter_chunk_states(k_c, v_c, b_c, s0)
    o_inter = jnp.einsum('bhnck,bhnkv->bhncv', q_c * jnp.exp(b_c), s_prev)
    b_mid = b_c[:, :, :, CHUNK // 2 - 1:CHUNK // 2]
    a = jnp.einsum('bhnck,bhnsk->bhncs', q_c * jnp.exp(b_c - b_mid), k_c * jnp.exp(b_mid - b_c))
    a = jnp.where(jnp.tril(jnp.ones((CHUNK, CHUNK), dtype=bool)), a, 0.0)
    o_intra = jnp.einsum('bhncs,bhnsv->bhncv', a, v_c)
    return (o_inter + o_intra).reshape(b, h, t, -1)


def gla_final_state(k, v, log_f, s0):
    k_c, v_c = _chunk(k), _chunk(v)
    b_c = jnp.cumsum(_chunk(log_f), axis=3)
    _, s_final = _inter_chunk_states(k_c, v_c, b_c, s0)
    return s_final


def _rev(a):
    return jnp.flip(a, axis=2)


def _hgrn2_gates(h, w_in, lb):
    f_f, f_b, i = jnp.split((h @ w_in[:, : 3 * HGRN_WIDTH]).astype(jnp.float32), 3, axis=-1)
    out = []
    for d, f_pre in enumerate((f_f, f_b)):
        f = lb[d] + (1.0 - lb[d]) * jax.nn.sigmoid(f_pre)
        out.append((_heads(1.0 - f), _heads(jnp.log(f))))
    return out[0], out[1], _heads(i)


def hgrn2_final_states(h, w_in, lb):
    (k_f, lf_f), (k_b, lf_b), v = _hgrn2_gates(h, w_in, lb)
    zeros = jnp.zeros(v.shape[:2] + (HGRN_HEAD_DIM, HGRN_HEAD_DIM), jnp.float32)
    s_f = gla_final_state(k_f, v, lf_f, zeros)
    s_b = gla_final_state(_rev(k_b), _rev(v), _rev(lf_b), zeros)
    return s_f, s_b


def hgrn2_mixer(h, w_in, lb, gnorm_w, w_out, s0_f, s0_b):
    bsz, t, _ = h.shape
    (k_f, lf_f), (k_b, lf_b), v = _hgrn2_gates(h, w_in, lb)
    q, z = jnp.split(h @ w_in[:, 3 * HGRN_WIDTH:], 2, axis=-1)
    q = _heads(jax.nn.silu(q).astype(jnp.float32)) * (HGRN_HEAD_DIM ** -0.5)
    o_f = gla_forward(q, k_f, v, lf_f, s0_f)
    o_b = _rev(gla_forward(_rev(q), _rev(k_b), _rev(v), _rev(lf_b), s0_b))
    o = (o_f + o_b).transpose(0, 2, 1, 3)
    o = rmsnorm(o, gnorm_w.reshape(HGRN_HEADS, HGRN_HEAD_DIM))
    o = o.reshape(bsz, t, HGRN_WIDTH).astype(h.dtype) * jax.nn.silu(z)
    return o @ w_out


def _centred_mean(u, w):
    length = u.shape[-2]
    csum = jnp.concatenate([jnp.zeros_like(u[..., :1, :]), jnp.cumsum(u, axis=-2)], axis=-2)
    t = jnp.arange(length)
    lo = jnp.clip(t - w // 2, 0, length)
    hi = jnp.clip(t - w // 2 + w, 0, length)
    s = jnp.take(csum, hi, axis=-2) - jnp.take(csum, lo, axis=-2)
    return s / (hi - lo).astype(u.dtype)[:, None]


def pool_mixer(h, rows, row_len, w_in, w_grp, scale, w_out):
    bsz, t, _ = h.shape
    u, z = jnp.split(h @ w_in, 2, axis=-1)
    ug = u.astype(jnp.float32).reshape(bsz, rows, row_len, POOL_GROUPS, POOL_GROUP_DIM)
    pooled = jnp.stack([_centred_mean(ug[..., g, :], w) for g, w in enumerate(POOL_WINDOWS)], axis=-2) - ug
    y = jnp.einsum('brwgi,gio->brwgo', pooled, w_grp).reshape(bsz, t, POOL_WIDTH) * scale
    return (y.astype(h.dtype) * jax.nn.silu(z)) @ w_out


def setup_inputs(seed: int = 0) -> dict:
    key = jax.random.key(seed)
    ks = jax.random.split(key, 18)
    d, e, g = D_MODEL, HGRN_WIDTH, POOL_GROUP_DIM
    n = jax.random.normal
    return {
        'x': n(ks[0], (BATCH, SEQ, d), jnp.float32),
        'c': n(ks[1], (BATCH, d), jnp.float32),
        'ctx': n(ks[2], (BATCH, CTX_LEN, d), jnp.float32),
        'c_ctx': n(ks[3], (d,), jnp.float32),
        'ada_w': n(ks[4], (DEPTH, d, 3 * d), jnp.float32) * (0.5 * d ** -0.5),
        'ada_b': n(ks[5], (DEPTH, 3 * d), jnp.float32) * 0.02,
        'norm_w': 1.0 + 0.05 * n(ks[6], (DEPTH, d), jnp.float32),
        'hgrn_w_in': n(ks[7], (N_HGRN_LAYERS, d, 5 * e), jnp.float32) * d ** -0.5,
        'hgrn_lb_logits': 0.1 * n(ks[8], (N_HGRN_LAYERS, 2, e), jnp.float32),
        'hgrn_gnorm_w': 1.0 + 0.05 * n(ks[9], (N_HGRN_LAYERS, e), jnp.float32),
        'hgrn_w_out': n(ks[10], (N_HGRN_LAYERS, e, d), jnp.float32) * e ** -0.5,
        'pool_w_in': n(ks[11], (N_POOL_LAYERS, d, 2 * POOL_WIDTH), jnp.float32) * d ** -0.5,
        'pool_w_grp': n(ks[12], (N_POOL_LAYERS, POOL_GROUPS, g, g), jnp.float32) * g ** -0.5,
        'pool_scale': 1.0 + 0.05 * n(ks[13], (N_POOL_LAYERS, POOL_WIDTH), jnp.float32),
        'pool_w_out': n(ks[14], (N_POOL_LAYERS, POOL_WIDTH, d), jnp.float32) * POOL_WIDTH ** -0.5,
        'final_norm_w': 1.0 + 0.05 * n(ks[15], (d,), jnp.float32),
    }


def reference(x, c, ctx, c_ctx, ada_w, ada_b, norm_w, hgrn_w_in, hgrn_lb_logits, hgrn_gnorm_w,
              hgrn_w_out, pool_w_in, pool_w_grp, pool_scale, pool_w_out, final_norm_w):
    rows = x.shape[1] // GRID_W
    lbs = lower_bounds(hgrn_lb_logits)
    h_ctx = ctx
    for i in range(DEPTH):
        is_hgrn = (i % N_MIXERS == 0)
        j = i // N_MIXERS
        ctx_update = any(l % N_MIXERS == 0 for l in range(i + 1, DEPTH))
        shift, scale, gate = _adaln(c, ada_w[i], ada_b[i])
        hx = rmsnorm(x, norm_w[i]) * (1.0 + scale) + shift
        if is_hgrn or ctx_update:
            c_shift, c_scale, c_gate = _adaln(c_ctx[None, :], ada_w[i], ada_b[i])
            hc = rmsnorm(h_ctx, norm_w[i]) * (1.0 + c_scale) + c_shift
        if is_hgrn:
            s_f, s_b = hgrn2_final_states(hc, hgrn_w_in[j], lbs[j])
            x = x + gate * hgrn2_mixer(hx, hgrn_w_in[j], lbs[j], hgrn_gnorm_w[j], hgrn_w_out[j], s_f, s_b)
            if ctx_update:
                zeros = jnp.zeros_like(s_f)
                h_ctx = h_ctx + c_gate * hgrn2_mixer(hc, hgrn_w_in[j], lbs[j], hgrn_gnorm_w[j], hgrn_w_out[j], zeros, zeros)
        else:
            x = x + gate * pool_mixer(hx, rows, GRID_W, pool_w_in[j], pool_w_grp[j], pool_scale[j], pool_w_out[j])
            if ctx_update:
                h_ctx = h_ctx + c_gate * pool_mixer(hc, 1, hc.shape[1], pool_w_in[j], pool_w_grp[j], pool_scale[j], pool_w_out[j])
    return rmsnorm(x, final_norm_w)
```

```cpp
#include <hip/hip_runtime.h>
#include <hip/hip_cooperative_groups.h>
#include <cstdio>
#include <cstdint>
namespace cg = cooperative_groups;
#ifndef MK_N_LAUNCHES
#define MK_N_LAUNCHES 12
#endif
namespace pg8 {
#define PG8_LAS __attribute__((address_space(3)))
typedef unsigned short bf16_t;
typedef short bf16x8 __attribute__((ext_vector_type(8)));
typedef float f32x4 __attribute__((ext_vector_type(4)));
typedef unsigned u32x4 __attribute__((ext_vector_type(4)));
constexpr int BM = 256, BK = 64, HALF = 128, HTB = HALF * BK * 2  , STAGE_BYTES = 8 * HTB, NXCD = 8, WGM = 8;

__host__ __device__ __forceinline__ int lds_byte(int r, int c) { const int st = (r >> 4) * 2 + (c >> 5), rr = r & 15, cc = c & 31, ob = rr * 64 + cc * 2; return st * 1024 + (ob ^ (((ob >> 9) & 1) << 5)); }
__host__ __device__ __forceinline__ void stage_rc(int b, int& R, int& C) { const int st = b / 1024, sb = b % 1024, swz = sb ^ (((sb >> 9) & 1) << 5); R = (st >> 1) * 16 + swz / 64; C = (st & 1) * 32 + (swz % 64) / 2; }
__host__ __device__ __forceinline__ int perm32(int rho) { const int n = rho >> 4, i = rho & 15; return 8 * (i >> 2) + 4 * n + (i & 3); }

struct Unit { int pm, pn; };
struct Gemm { const bf16_t* A; const bf16_t* Bt; int M, N, K, lda, ldb, a_pn_bytes; };

struct StaticOrder {
    int nM, nN, nwg, G, c;
    __host__ __device__ void init(int M, int N, int G_, int c_) { nM = M / BM; nN = N / BM; nwg = nM * nN; G = G_; c = c_; }
    __host__ __device__ bool next(int i, Unit& u) const {
        const long L = (long)i * G + c; if (L >= nwg) return false;
        int wgid = (int)L; { const int q = nwg / NXCD, r = nwg % NXCD, xcd = wgid % NXCD, off = wgid / NXCD; wgid = (xcd < r ? xcd * (q + 1) : r * (q + 1) + (xcd - r) * q) + off; }
        const int nig = WGM * nN, gid = wgid / nig, fm = gid * WGM, gsz = (nM - fm) < WGM ? (nM - fm) : WGM;
        u.pm = fm + ((wgid % nig) % gsz); u.pn = (wgid % nig) / gsz; return true;
    }
    __device__ __forceinline__ void a_ready(const Unit&) const {}
    __device__ __forceinline__ void done(const Unit&) const {}
};
__device__ __forceinline__ unsigned cvt_pk_bf16(float lo, float hi) { unsigned r; asm volatile("v_cvt_pk_bf16_f32 %0, %1, %2" : "=v"(r) : "v"(lo), "v"(hi)); return r; }
template <class Epi, class Sched>
__device__ __forceinline__ void gemm_phase(PG8_LAS unsigned char* lds, const Gemm g, const Sched& S, const Epi& E, const int wave_s) {
    int tid_ = wave_s * 64 + (int)__builtin_amdgcn_mbcnt_hi(~0u, __builtin_amdgcn_mbcnt_lo(~0u, 0u)); const int tid = tid_, wid = __builtin_amdgcn_readfirstlane(tid >> 6), lane = tid & 63, wr = wid >> 2, wc = wid & 3, fr = lane & 15, fq = lane >> 4;
    const int K = g.K, nt = K / BK;
    unsigned voffA[2], voffB[2];
#pragma unroll
    for (int i = 0; i < 2; ++i) { int R, C; stage_rc(tid * 16 + i * 8192, R, C); const int Rb = Epi::PERM ? ((R & ~31) + perm32(R & 31)) : R;
        voffA[i] = (unsigned)(R * g.lda + C) * 2u; voffB[i] = (unsigned)(Rb * g.ldb + C) * 2u; }
    const size_t kstep = (size_t)(BK * 2);
    const size_t hstepA = (size_t)HALF * g.lda * 2, hstepB = (size_t)HALF * g.ldb * 2;
    const size_t tstepA = 2 * hstepA, tstepB = 2 * hstepB;
    const unsigned ldsw = (unsigned)wid * 1024u;
    const int aoff = lds_byte(wr * 64 + fr, fq * 8), boff = lds_byte(wc * 32 + fr, fq * 8);
#define PG8_SA(b, h) (((b) * 2 + (h)) * HTB)
#define PG8_SB(b, h) ((4 + (b) * 2 + (h)) * HTB)
#define PG8_STAGE(bufoff, gbase, voff) do { _Pragma("unroll") for (int _i = 0; _i < 2; ++_i) \
        __builtin_amdgcn_global_load_lds((const unsigned*)((const char*)(gbase) + (voff)[_i]), (PG8_LAS unsigned*)(lds + (bufoff) + ldsw + _i * 8192), 16, 0, 0); } while (0)
#define PG8_LDA(dst, b, h) do { _Pragma("unroll") for (int m = 0; m < 4; ++m) _Pragma("unroll") for (int k = 0; k < 2; ++k) dst[m][k] = *(const PG8_LAS bf16x8*)(lds + PG8_SA(b, h) + aoff + m * 2048 + k * 1024); } while (0)
#define PG8_LDB(dst, b, h) do { _Pragma("unroll") for (int n = 0; n < 2; ++n) _Pragma("unroll") for (int k = 0; k < 2; ++k) dst[n][k] = *(const PG8_LAS bf16x8*)(lds + PG8_SB(b, h) + boff + n * 2048 + k * 1024); } while (0)
#define PG8_MMA(ai, bj, At, Bt) do { __builtin_amdgcn_s_setprio(1); _Pragma("unroll") for (int m = 0; m < 4; ++m) _Pragma("unroll") for (int n = 0; n < 2; ++n) _Pragma("unroll") for (int k = 0; k < 2; ++k) \
        acc[ai][bj][m][n] = __builtin_amdgcn_mfma_f32_16x16x32_bf16(Bt[n][k], At[m][k], acc[ai][bj][m][n], 0, 0, 0); __builtin_amdgcn_s_setprio(0); } while (0)
#define PG8_WAIT_V(n) asm volatile("s_waitcnt vmcnt(" #n ")" ::: "memory")
#define PG8_WAIT_L(n) asm volatile("s_waitcnt lgkmcnt(" #n ")" ::: "memory")
#define PG8_BAR __builtin_amdgcn_s_barrier()
#define PG8_SCHED __builtin_amdgcn_sched_barrier(0)
    Unit cur, nxt; int ui = 0;
    if (!S.next(0, cur)) return;
    f32x4 acc[2][2][4][2];
#pragma unroll
    for (int a = 0; a < 2; ++a)
#pragma unroll
        for (int b = 0; b < 2; ++b)
#pragma unroll
            for (int m = 0; m < 4; ++m)
#pragma unroll
                for (int n = 0; n < 2; ++n) acc[a][b][m][n] = (f32x4){0.f, 0.f, 0.f, 0.f};
    bf16x8 At[4][2], B0[2][2], B1[2][2];
    const char* cA = (const char*)g.A + (size_t)cur.pm * tstepA + (size_t)cur.pn * g.a_pn_bytes; const char* cB = (const char*)g.Bt + (size_t)cur.pn * tstepB;
    S.a_ready(cur);
    PG8_STAGE(PG8_SB(0, 0), cB, voffB); PG8_STAGE(PG8_SA(0, 0), cA, voffA); PG8_STAGE(PG8_SB(0, 1), cB + hstepB, voffB); PG8_STAGE(PG8_SA(0, 1), cA + hstepA, voffA);
    if (wr == 1) PG8_BAR;
    PG8_WAIT_V(4); PG8_BAR;
    PG8_STAGE(PG8_SB(1, 0), cB + kstep, voffB); PG8_STAGE(PG8_SA(1, 0), cA + kstep, voffA); PG8_STAGE(PG8_SB(1, 1), cB + hstepB + kstep, voffB);
    PG8_WAIT_V(6); PG8_BAR;
    for (;;) {
        const bool has_next = S.next(ui + 1, nxt);
        const char* nA = has_next ? (const char*)g.A + (size_t)nxt.pm * tstepA + (size_t)nxt.pn * g.a_pn_bytes : cA; const char* nB = has_next ? (const char*)g.Bt + (size_t)nxt.pn * tstepB : cB;
        for (int t = 0; t < nt; t += 2) {
            const bool last = (t == nt - 2);
            const char* a1 = cA + (size_t)(t + 1) * kstep;
            const char* a2 = last ? nA : cA + (size_t)(t + 2) * kstep; const char* b2 = last ? nB : cB + (size_t)(t + 2) * kstep;
            const char* a3 = a2 + kstep; const char* b3 = b2 + kstep;
            if (last && has_next) S.a_ready(nxt);
            PG8_LDB(B0, 0, 0); PG8_SCHED; PG8_LDA(At, 0, 0); PG8_STAGE(PG8_SA(1, 1), a1 + hstepA, voffA);
            PG8_WAIT_L(8); PG8_BAR; PG8_WAIT_L(0); PG8_MMA(0, 0, At, B0); PG8_BAR; PG8_SCHED;
            PG8_LDB(B1, 0, 1); PG8_STAGE(PG8_SB(0, 0), b2, voffB);
            PG8_BAR; PG8_WAIT_L(0); PG8_MMA(0, 1, At, B1); PG8_BAR;
            PG8_LDA(At, 0, 1); PG8_STAGE(PG8_SA(0, 0), a2, voffA);
            PG8_BAR; PG8_WAIT_L(0); PG8_MMA(1, 0, At, B0); PG8_BAR; PG8_SCHED;
            PG8_STAGE(PG8_SB(0, 1), b2 + hstepB, voffB);
            PG8_WAIT_V(6); PG8_BAR; PG8_MMA(1, 1, At, B1); PG8_BAR;
            PG8_LDB(B0, 1, 0); PG8_SCHED; PG8_LDA(At, 1, 0); PG8_STAGE(PG8_SA(0, 1), a2 + hstepA, voffA);
            PG8_WAIT_L(8); PG8_BAR; PG8_WAIT_L(0); PG8_MMA(0, 0, At, B0); PG8_BAR; PG8_SCHED;
            PG8_LDB(B1, 1, 1); PG8_STAGE(PG8_SB(1, 0), b3, voffB);
            PG8_BAR; PG8_WAIT_L(0); PG8_MMA(0, 1, At, B1); PG8_BAR;
            PG8_LDA(At, 1, 1); PG8_STAGE(PG8_SA(1, 0), a3, voffA);
            PG8_BAR; PG8_WAIT_L(0); PG8_MMA(1, 0, At, B0); PG8_BAR; PG8_SCHED;
            PG8_STAGE(PG8_SB(1, 1), b3 + hstepB, voffB);
            PG8_WAIT_V(6); PG8_BAR; PG8_MMA(1, 1, At, B1); PG8_BAR;
        }
        if constexpr (!Epi::AFTER_DRAIN) { E(acc, cur, wr, wc, fr, fq); S.done(cur); }
        if (!has_next) break;
#pragma unroll
        for (int a = 0; a < 2; ++a)
#pragma unroll
            for (int b = 0; b < 2; ++b)
#pragma unroll
                for (int m = 0; m < 4; ++m)
#pragma unroll
                    for (int n = 0; n < 2; ++n) acc[a][b][m][n] = (f32x4){0.f, 0.f, 0.f, 0.f};
        cur = nxt; cA = nA; cB = nB; ++ui;
    }
    PG8_WAIT_V(0);
    if (wr == 0) PG8_BAR;
    PG8_BAR;
    if constexpr (Epi::AFTER_DRAIN) { E.fused(acc, cur, wr, wc, fr, fq, lds, wid, lane); S.done(cur); }
#undef PG8_SA
#undef PG8_SB
#undef PG8_STAGE
#undef PG8_LDA
#undef PG8_LDB
#undef PG8_MMA
#undef PG8_WAIT_V
#undef PG8_WAIT_L
#undef PG8_BAR
#undef PG8_SCHED
}
}

constexpr int BATCH = 8, SEQ = 2048, D = 1024, CTX = 256;
constexpr int MT = BATCH * SEQ;
constexpr int MC = BATCH * CTX;
constexpr int MA = MT + MC;
constexpr float EPS = 1e-6f;
constexpr int NPHASE = 12;
constexpr size_t MiB = 1u << 20;
constexpr size_t WS_MOD = 0;
constexpr size_t WS_LB = 512 * 1024;
constexpr size_t WS_W0T = 1 * MiB;
constexpr size_t WS_W1T = 11 * MiB;
constexpr size_t WS_W2T = 13 * MiB;
constexpr size_t WS_WGT = 17 * MiB;
constexpr size_t WS_W3T = 18 * MiB;
constexpr size_t WS_FF = 20 * MiB;
constexpr size_t WS_FB = 56 * MiB;
constexpr size_t WS_V = 92 * MiB;
constexpr size_t WS_Q = 128 * MiB;
constexpr size_t WS_Z = 160 * MiB;
constexpr size_t WS_OB = 192 * MiB;
constexpr size_t WS_A1 = 20 * MiB;
constexpr size_t WS_X1 = 64 * MiB;
constexpr size_t WS_A2 = 128 * MiB;
constexpr size_t WS_U = 192 * MiB;
constexpr size_t WS_ZP = 160 * MiB;
constexpr size_t WS_A3 = 20 * MiB;
constexpr size_t WS_A4 = 128 * MiB;
constexpr size_t WS_END = 256 * MiB;

constexpr int LDS_BYTES = 131072;

#define LAS __attribute__((address_space(3)))
typedef unsigned short bf16;
typedef unsigned v4u __attribute__((ext_vector_type(4)));
typedef unsigned v2u __attribute__((ext_vector_type(2)));
typedef float f32x4 __attribute__((ext_vector_type(4)));
typedef float f32x2 __attribute__((ext_vector_type(2)));
typedef short bf16x8 __attribute__((ext_vector_type(8)));
#define LDS_WAIT() asm volatile("s_waitcnt lgkmcnt(0)" ::: "memory")

__device__ __forceinline__ unsigned pk2(float lo, float hi) { unsigned r; asm volatile("v_cvt_pk_bf16_f32 %0, %1, %2" : "=v"(r) : "v"(lo), "v"(hi)); return r; }
__device__ __forceinline__ float bflo(unsigned u) { return __builtin_bit_cast(float, u << 16); }
__device__ __forceinline__ float bfhi(unsigned u) { return __builtin_bit_cast(float, u & 0xffff0000u); }
__device__ __forceinline__ float fast_rcp(float x) { return __builtin_amdgcn_rcpf(x); }
__device__ __forceinline__ float sigmoidf_(float x) { return fast_rcp(1.f + __expf(-x)); }
__device__ __forceinline__ float siluf_(float x) { return x * sigmoidf_(x); }
__device__ __forceinline__ float wave_sum(float v) {
#pragma unroll
    for (int o = 1; o < 64; o <<= 1) v += __shfl_xor(v, o);
    return v;
}

struct Args { const float* in[16]; float* out; unsigned char* ws; int ph_lo, ph_hi; };
#define GAS __attribute__((address_space(1)))
#define CAS __attribute__((address_space(4)))
__device__ __forceinline__ const unsigned char CAS* karg_base() { const unsigned char CAS* p = (const unsigned char CAS*)__builtin_amdgcn_kernarg_segment_ptr(); asm volatile("" : "+s"(p)); return p; }
__device__ __forceinline__ unsigned long long karg_u64(int off) { return *(const unsigned long long CAS*)(karg_base() + off); }
__device__ __forceinline__ int karg_i32(int off) { return *(const int CAS*)(karg_base() + off); }
#define KA_IN(i) ((const float*)(const float GAS*)karg_u64(8 * (i)))
#define KA_OUT() ((float*)(float GAS*)karg_u64(128))
#define KA_WS() ((unsigned char*)(unsigned char GAS*)karg_u64(136))
static_assert(sizeof(Args) == 152, "Args layout");

struct EpiInProj {
    static constexpr bool PERM = true, AFTER_DRAIN = false;
    unsigned char* ws; int row_off;
    __device__ __forceinline__ void operator()(const f32x4 (&acc)[2][2][4][2], const pg8::Unit& u, int wr, int wc, int fr, int fq) const {
        const int type = u.pn >> 2, colt = (u.pn & 3) * 256;
        const int row0 = row_off + u.pm * 256 + wr * 64 + fr, col0 = colt + wc * 32 + 8 * fq;
        if (type < 2) {
            bf16* F = (bf16*)(ws + (type == 0 ? WS_FF : WS_FB)); const float* lbp = (const float*)(ws + WS_LB) + type * 1024 + col0;
            f32x4 lv[2][2];
#pragma unroll
            for (int bj = 0; bj < 2; ++bj)
#pragma unroll
                for (int n = 0; n < 2; ++n) lv[bj][n] = *(const f32x4*)(lbp + bj * 128 + 4 * n);
#pragma unroll
            for (int ai = 0; ai < 2; ++ai)
#pragma unroll
                for (int m = 0; m < 4; ++m) { bf16* rowp = F + (size_t)(row0 + ai * 128 + m * 16) * 1024 + col0;
#pragma unroll
                    for (int bj = 0; bj < 2; ++bj) { unsigned o[4];
#pragma unroll
                        for (int n = 0; n < 2; ++n) { float q[4];
#pragma unroll
                            for (int e = 0; e < 4; ++e) { const float l = lv[bj][n][e]; const float f = l + (1.f - l) * sigmoidf_(acc[ai][bj][m][n][e]);
                                q[e] = __builtin_rintf(f * 65535.f); }
                            o[2 * n] = (unsigned)q[0] | ((unsigned)q[1] << 16); o[2 * n + 1] = (unsigned)q[2] | ((unsigned)q[3] << 16); }
                        *(v4u*)(rowp + bj * 128) = (v4u){o[0], o[1], o[2], o[3]}; } }
        } else {
            bf16* O = (bf16*)(ws + (type == 2 ? WS_V : (type == 3 ? WS_Q : WS_Z)));
            if (type >= 3 && row_off != 0) return;
            const float qs = type == 3 ? 0.08838834764831845f : 1.f;
#pragma unroll
            for (int ai = 0; ai < 2; ++ai)
#pragma unroll
                for (int m = 0; m < 4; ++m) { bf16* rowp = O + (size_t)(row0 + ai * 128 + m * 16) * 1024 + col0;
#pragma unroll
                    for (int bj = 0; bj < 2; ++bj) { f32x4 v0 = acc[ai][bj][m][0], v1 = acc[ai][bj][m][1];
                        if (type >= 3) {
#pragma unroll
                            for (int e = 0; e < 4; ++e) { v0[e] = siluf_(v0[e]) * qs; v1[e] = siluf_(v1[e]) * qs; } }
                        *(v4u*)(rowp + bj * 128) = (v4u){pk2(v0[0], v0[1]), pk2(v0[2], v0[3]), pk2(v1[0], v1[1]), pk2(v1[2], v1[3])}; } }
        }
    }
};
struct EpiResid {
    static constexpr bool PERM = false, AFTER_DRAIN = false;
    const float* xin; float* out; const float* gate;
    __device__ __forceinline__ void operator()(const f32x4 (&acc)[2][2][4][2], const pg8::Unit& u, int wr, int wc, int fr, int fq) const {
        const int row0 = u.pm * 256 + wr * 64 + fr, col0 = u.pn * 256 + wc * 32 + 4 * fq;
        const float* gp = gate + (size_t)(u.pm >> 3) * 3072 + col0;
        f32x4 gv[2][2];
#pragma unroll
        for (int bj = 0; bj < 2; ++bj)
#pragma unroll
            for (int n = 0; n < 2; ++n) gv[bj][n] = *(const f32x4*)(gp + bj * 128 + n * 16);
#pragma unroll
        for (int ai = 0; ai < 2; ++ai)
#pragma unroll
            for (int m = 0; m < 4; ++m) { const size_t ro = (size_t)(row0 + ai * 128 + m * 16) * 1024 + col0;
#pragma unroll
                for (int bj = 0; bj < 2; ++bj)
#pragma unroll
                    for (int n = 0; n < 2; ++n) { const f32x4 xv = *(const f32x4*)(xin + ro + bj * 128 + n * 16);
                        *(f32x4*)(out + ro + bj * 128 + n * 16) = xv + gv[bj][n] * acc[ai][bj][m][n]; } }
    }
};
struct EpiPoolIn {
    static constexpr bool PERM = true, AFTER_DRAIN = false;
    float* U; bf16* ZP;
    __device__ __forceinline__ void operator()(const f32x4 (&acc)[2][2][4][2], const pg8::Unit& u, int wr, int wc, int fr, int fq) const {
        const int type = u.pn >> 2, colt = (u.pn & 3) * 256;
        const int row0 = u.pm * 256 + wr * 64 + fr, col0 = colt + wc * 32 + 8 * fq;
#pragma unroll
        for (int ai = 0; ai < 2; ++ai)
#pragma unroll
            for (int m = 0; m < 4; ++m) { const size_t ro = (size_t)(row0 + ai * 128 + m * 16) * 1024 + col0;
#pragma unroll
                for (int bj = 0; bj < 2; ++bj) { f32x4 v0 = acc[ai][bj][m][0], v1 = acc[ai][bj][m][1];
                    if (type == 0) { *(f32x4*)(U + ro + bj * 128) = v0; *(f32x4*)(U + ro + bj * 128 + 4) = v1; }
                    else {
#pragma unroll
                        for (int e = 0; e < 4; ++e) { v0[e] = siluf_(v0[e]); v1[e] = siluf_(v1[e]); }
                        *(v4u*)(ZP + ro + bj * 128) = (v4u){pk2(v0[0], v0[1]), pk2(v0[2], v0[3]), pk2(v1[0], v1[1]), pk2(v1[2], v1[3])}; } } }
    }
};
struct EpiGrp {
    static constexpr bool PERM = true, AFTER_DRAIN = false;
    bf16* A4; const float* scale; const bf16* ZP;
    __device__ __forceinline__ void operator()(const f32x4 (&acc)[2][2][4][2], const pg8::Unit& u, int wr, int wc, int fr, int fq) const {
        const int row0 = u.pm * 256 + wr * 64 + fr, col0 = u.pn * 256 + wc * 32 + 8 * fq;
#pragma unroll
        for (int ai = 0; ai < 2; ++ai)
#pragma unroll
            for (int m = 0; m < 4; ++m) { const size_t ro = (size_t)(row0 + ai * 128 + m * 16) * 1024 + col0;
#pragma unroll
                for (int bj = 0; bj < 2; ++bj) { const v4u zz = *(const v4u*)(ZP + ro + bj * 128);
                    const f32x4 v0 = acc[ai][bj][m][0] * *(const f32x4*)(scale + col0 + bj * 128), v1 = acc[ai][bj][m][1] * *(const f32x4*)(scale + col0 + bj * 128 + 4);
                    *(v4u*)(A4 + ro + bj * 128) = (v4u){pk2(v0[0] * bflo(zz[0]), v0[1] * bfhi(zz[0])), pk2(v0[2] * bflo(zz[1]), v0[3] * bfhi(zz[1])),
                                                         pk2(v1[0] * bflo(zz[2]), v1[1] * bfhi(zz[2])), pk2(v1[2] * bflo(zz[3]), v1[3] * bfhi(zz[3]))}; } }
    }
};
__device__ __forceinline__ void transpose_item(const float* W, int K, int N, bf16* WT, int row_off, LAS float* scr, int item, int lane) {
    const int nblk = N / 32, kb = item / nblk, nb = item % nblk, k0 = 64 * kb, n0 = 32 * nb;
#pragma unroll 8
    for (int i = 0; i < 32; ++i) { const int kk = 2 * i + (lane >> 5); scr[kk * 33 + (lane & 31)] = W[(size_t)(k0 + kk) * N + n0 + (lane & 31)]; }
    LDS_WAIT(); asm volatile("" ::: "memory");
    const int c = lane & 7;
#pragma unroll
    for (int j = 0; j < 4; ++j) { const int n = (lane >> 3) + 8 * j; const LAS float* s = scr + (8 * c) * 33 + n;
        v4u o; o.x = pk2(s[0 * 33], s[1 * 33]); o.y = pk2(s[2 * 33], s[3 * 33]); o.z = pk2(s[4 * 33], s[5 * 33]); o.w = pk2(s[6 * 33], s[7 * 33]);
        *(v4u*)(WT + (size_t)(row_off + n0 + n) * K + k0 + 8 * c) = o; }
    LDS_WAIT(); asm volatile("" ::: "memory");
}

__device__ __forceinline__ void phase_prologue(const Args& a, LAS unsigned char* lds, const int wave_s) {
    int tid_ = wave_s * 64 + (int)__builtin_amdgcn_mbcnt_hi(~0u, __builtin_amdgcn_mbcnt_lo(~0u, 0u)); const int tid = tid_, lane = tid & 63, wave = __builtin_amdgcn_readfirstlane(tid >> 6);
    const float* c = KA_IN(1); const float* cctx = KA_IN(3); const float* ada_w = KA_IN(4); const float* ada_b = KA_IN(5);
    float* MOD = (float*)(KA_WS() + WS_MOD);
    LAS float* sil = (LAS float*)(lds + 69632);
    LAS float* red = sil + 9 * 1024;
    bool have_sil = false;
    for (int task = blockIdx.x; task < 192; task += gridDim.x) {
        if (!have_sil) {
            for (int i = tid; i < 9 * 1024; i += 512) { const float v = i < 8192 ? c[i] : cctx[i - 8192]; sil[i] = siluf_(v); }
            have_sil = true;
        }
        __syncthreads();
        const int l = task / 96, n0 = (task % 96) * 32;
        const float* W = ada_w + (size_t)l * 1024 * 3072 + n0 + (lane & 31);
        float acc[9];
#pragma unroll
        for (int r = 0; r < 9; ++r) acc[r] = 0.f;
        const int kb = wave * 128 + (lane >> 5);
#pragma unroll 8
        for (int i = 0; i < 64; ++i) { const int k = kb + 2 * i; const float wv = W[(size_t)k * 3072];
#pragma unroll
            for (int r = 0; r < 9; ++r) acc[r] += sil[r * 1024 + k] * wv; }
#pragma unroll
        for (int r = 0; r < 9; ++r) acc[r] += __shfl_xor(acc[r], 32);
        if (lane < 32) {
#pragma unroll
            for (int r = 0; r < 9; ++r) red[(wave * 9 + r) * 32 + lane] = acc[r]; }
        __syncthreads();
        if (tid < 288) { const int r = tid >> 5, n = tid & 31; float s = 0.f;
#pragma unroll
            for (int w = 0; w < 8; ++w) s += red[(w * 9 + r) * 32 + n];
            MOD[(size_t)(l * 9 + r) * 3072 + n0 + n] = s + ada_b[l * 3072 + n0 + n]; }
    }
    if (blockIdx.x == gridDim.x - 1) { const float* lg = KA_IN(8); float* LB = (float*)(KA_WS() + WS_LB);
        for (int i = tid; i < 2048; i += 512) LB[i] = sigmoidf_(lg[i]); }
    LAS float* scr = (LAS float*)(lds + wave * 8448);
    const int gw = blockIdx.x * 8 + wave, NGW = gridDim.x * 8;
    constexpr int I0 = 16 * 160, I1 = 16 * 32, I2 = 16 * 64, IG = 4 * 8, I3 = 16 * 32;
    constexpr int NIT = I0 + I1 + I2 + 4 * IG + I3;
    for (int it = gw; it < NIT; it += NGW) {
        int r = it;
        if (r < I0) { transpose_item(KA_IN(7), 1024, 5120, (bf16*)(KA_WS() + WS_W0T), 0, scr, r, lane); continue; } r -= I0;
        if (r < I1) { transpose_item(KA_IN(10), 1024, 1024, (bf16*)(KA_WS() + WS_W1T), 0, scr, r, lane); continue; } r -= I1;
        if (r < I2) { transpose_item(KA_IN(11), 1024, 2048, (bf16*)(KA_WS() + WS_W2T), 0, scr, r, lane); continue; } r -= I2;
        if (r < 4 * IG) { const int g = r / IG; transpose_item(KA_IN(12) + (size_t)g * 65536, 256, 256, (bf16*)(KA_WS() + WS_WGT), g * 256, scr, r % IG, lane); continue; } r -= 4 * IG;
        transpose_item(KA_IN(14), 1024, 1024, (bf16*)(KA_WS() + WS_W3T), 0, scr, r, lane);
    }
}

__device__ __forceinline__ void modnorm_row(const float* xrow, const float* nw, const float* mod, bf16* orow, int lane) {
    const f32x4* xr = (const f32x4*)xrow + lane;
    f32x4 v[4]; float s = 0.f;
#pragma unroll
    for (int j = 0; j < 4; ++j) { v[j] = xr[64 * j]; s += (v[j].x * v[j].x + v[j].y * v[j].y) + (v[j].z * v[j].z + v[j].w * v[j].w); }
    const float rstd = __builtin_amdgcn_rsqf(wave_sum(s) * (1.f / 1024.f) + EPS);
    unsigned long long* o8 = (unsigned long long*)orow + lane;
#pragma unroll
    for (int j = 0; j < 4; ++j) { const f32x4 w4 = ((const f32x4*)nw)[lane + 64 * j], sh = ((const f32x4*)mod)[lane + 64 * j], sc = ((const f32x4*)(mod + 1024))[lane + 64 * j];
        const f32x4 y = v[j] * rstd * w4 * (sc + 1.f) + sh;
        o8[64 * j] = (unsigned long long)pk2(y.x, y.y) | ((unsigned long long)pk2(y.z, y.w) << 32); }
}
__device__ __forceinline__ void phase_modnorm(const Args& a, int layer, const float* xsrc, int nrows_x, bf16* dst, const int wave_s) {
    int tid_ = wave_s * 64 + (int)__builtin_amdgcn_mbcnt_hi(~0u, __builtin_amdgcn_mbcnt_lo(~0u, 0u)); const int lane = tid_ & 63, wave = tid_ >> 6;
    const int gw = blockIdx.x * 8 + wave, NGW = gridDim.x * 8;
    const float* MOD = (const float*)(KA_WS() + WS_MOD) + (size_t)layer * 9 * 3072;
    const float* nw = KA_IN(6) + layer * 1024;
    const int total = layer == 0 ? MA : nrows_x;
    for (int m = gw; m < total; m += NGW) {
        if (m < MT) modnorm_row(xsrc + (size_t)m * 1024, nw, MOD + (size_t)(m >> 11) * 3072, dst + (size_t)m * 1024, lane);
        else modnorm_row(KA_IN(2) + (size_t)(m - MT) * 1024, nw, MOD + (size_t)8 * 3072, dst + (size_t)m * 1024, lane);
    }
}
__device__ __forceinline__ void phase_headnorm(const Args& a, const int wave_s) {
    int tid_ = wave_s * 64 + (int)__builtin_amdgcn_mbcnt_hi(~0u, __builtin_amdgcn_mbcnt_lo(~0u, 0u)); const int lane = tid_ & 63, wave = tid_ >> 6;
    const int gw = blockIdx.x * 8 + wave, NGW = gridDim.x * 8;
    const float* OF = KA_OUT(); const float* OB = (const float*)(KA_WS() + WS_OB); const bf16* Z = (const bf16*)(KA_WS() + WS_Z); bf16* A1 = (bf16*)(KA_WS() + WS_A1);
    const float* gwt = KA_IN(9);
    for (int m = gw; m < MT; m += NGW) {
        const f32x4* pf = (const f32x4*)(OF + (size_t)m * 1024) + lane; const f32x4* pb = (const f32x4*)(OB + (size_t)m * 1024) + lane;
        const unsigned long long* pz = (const unsigned long long*)(Z + (size_t)m * 1024) + lane;
        unsigned long long* o8 = (unsigned long long*)(A1 + (size_t)m * 1024) + lane;
#pragma unroll
        for (int j = 0; j < 4; ++j) { const f32x4 o = pf[64 * j] + pb[64 * j];
            float s = (o.x * o.x + o.y * o.y) + (o.z * o.z + o.w * o.w);
#pragma unroll
            for (int sh = 1; sh < 32; sh <<= 1) s += __shfl_xor(s, sh);
            const float rstd = __builtin_amdgcn_rsqf(s * (1.f / 128.f) + EPS);
            const f32x4 w4 = ((const f32x4*)gwt)[lane + 64 * j]; const unsigned long long zz = pz[64 * j]; const unsigned z0 = (unsigned)zz, z1 = (unsigned)(zz >> 32);
            const f32x4 y = o * rstd * w4;
            o8[64 * j] = (unsigned long long)pk2(y.x * bflo(z0), y.y * bfhi(z0)) | ((unsigned long long)pk2(y.z * bflo(z1), y.w * bfhi(z1)) << 32); }
    }
}
__device__ __forceinline__ void phase_pool(const Args& a, LAS unsigned char* lds, const int wave_s) {
    int tid_ = wave_s * 64 + (int)__builtin_amdgcn_mbcnt_hi(~0u, __builtin_amdgcn_mbcnt_lo(~0u, 0u)); const int tid = tid_;
    LAS float* T = (LAS float*)lds;
    const float* Ub = (const float*)(KA_WS() + WS_U); bf16* A3 = (bf16*)(KA_WS() + WS_A3);
    for (int unit = blockIdx.x; unit < 1024; unit += gridDim.x) {
        const int g = unit & 3, br = unit >> 2;
        const float* U = Ub + (size_t)br * 64 * 1024 + g * 256;
#pragma unroll
        for (int i = 0; i < 8; ++i) { const int idx = tid + 512 * i, row = idx >> 6, c4 = idx & 63; *(LAS f32x4*)(T + row * 256 + 4 * c4) = *(const f32x4*)(U + (size_t)row * 1024 + 4 * c4); }
        __syncthreads();
        const int c = tid & 255, t0 = (tid >> 8) * 32, hw = 1 << g;
        int lo = max(t0 - hw, 0), hi = min(t0 + hw, 64); float s = 0.f;
        for (int j = lo; j < hi; ++j) s += T[j * 256 + c];
        bf16* op = A3 + (size_t)(br * 64) * 1024 + g * 256 + c;
        for (int t = t0; t < t0 + 32; ++t) {
            if (t > t0) { const int nlo = max(t - hw, 0), nhi = min(t + hw, 64);
                if (nhi > hi) s += T[(nhi - 1) * 256 + c];
                if (nlo > lo) s -= T[lo * 256 + c];
                lo = nlo; hi = nhi; }
            const float pooled = s / (float)(hi - lo) - T[t * 256 + c];
            op[(size_t)t * 1024] = (bf16)(pk2(pooled, 0.f) & 0xffffu);
        }
        __syncthreads();
    }
}
__device__ __forceinline__ void phase_final(const Args& a, const int wave_s) {
    int tid_ = wave_s * 64 + (int)__builtin_amdgcn_mbcnt_hi(~0u, __builtin_amdgcn_mbcnt_lo(~0u, 0u)); const int lane = tid_ & 63, wave = tid_ >> 6;
    const int gw = blockIdx.x * 8 + wave, NGW = gridDim.x * 8;
    const float* fw = KA_IN(15);
    for (int m = gw; m < MT; m += NGW) {
        f32x4* xr = (f32x4*)(KA_OUT() + (size_t)m * 1024) + lane;
        f32x4 v[4]; float s = 0.f;
#pragma unroll
        for (int j = 0; j < 4; ++j) { v[j] = xr[64 * j]; s += (v[j].x * v[j].x + v[j].y * v[j].y) + (v[j].z * v[j].z + v[j].w * v[j].w); }
        const float rstd = __builtin_amdgcn_rsqf(wave_sum(s) * (1.f / 1024.f) + EPS);
#pragma unroll
        for (int j = 0; j < 4; ++j) xr[64 * j] = v[j] * rstd * ((const f32x4*)fw)[lane + 64 * j];
    }
}
constexpr int QS_OFF = 0, KS_OFF = 17408, KST_OFF = 34816, VT_OFF = 53248, SPT_OFF = 62464, TOT_OFF = 79872;
__device__ __forceinline__ f32x4 mfma16(bf16x8 a, bf16x8 b, f32x4 c) { return __builtin_amdgcn_mfma_f32_16x16x32_bf16(a, b, c, 0, 0, 0); }
__device__ __forceinline__ bf16x8 as_bf16x8(v4u v) { return __builtin_bit_cast(bf16x8, v); }

__device__ __forceinline__ void phase_gla(const Args& a, LAS unsigned char* lds, const int wave_s) {
    int tid_ = wave_s * 64 + (int)__builtin_amdgcn_mbcnt_hi(~0u, __builtin_amdgcn_mbcnt_lo(~0u, 0u)); const int tid = tid_, lane = tid & 63, w = __builtin_amdgcn_readfirstlane(tid >> 6), fr = lane & 15, fq = lane >> 4;
    const bf16* FFq = (const bf16*)(KA_WS() + WS_FF); const bf16* FBq = (const bf16*)(KA_WS() + WS_FB);
    const bf16* Vb = (const bf16*)(KA_WS() + WS_V); const bf16* Qb = (const bf16*)(KA_WS() + WS_Q);
    float* OF = KA_OUT(); float* OB = (float*)(KA_WS() + WS_OB);
    LAS unsigned char* QS = lds + QS_OFF; LAS unsigned char* KS = lds + KS_OFF; LAS unsigned char* KST = lds + KST_OFF;
    LAS unsigned char* VT = lds + VT_OFF; LAS unsigned char* SPT = lds + SPT_OFF; LAS float* TOT = (LAS float*)(lds + TOT_OFF);
    const int ci = w & 3, vh = w >> 2;
    for (int u = blockIdx.x; u < 256; u += gridDim.x) {
        const int vs = (u >> 3) & 1, rest = (u & 7) | ((u >> 4) << 3), dir = rest & 1, h = (rest >> 1) & 7, b = rest >> 4;
        const bf16* Fq = dir ? FBq : FFq; float* O = dir ? OB : OF;
        f32x4 S[4];
#pragma unroll
        for (int i = 0; i < 4; ++i) S[i] = (f32x4){0.f, 0.f, 0.f, 0.f};
        unsigned fraw[8], qraw[8]; unsigned vraw[8];
#define GLA_ROWBASE(i) ((i) < 4 ? (MT + b * 256 + (dir ? 3 - (i) : (i)) * 64) : (b * 2048 + (dir ? 35 - (i) : (i) - 4) * 64))
#define GLA_LOAD(i) do { const int _rb = GLA_ROWBASE(i); \
        _Pragma("unroll") for (int jj = 0; jj < 8; ++jj) { const int _r = 8 * w + jj; const size_t _g = (size_t)(_rb + (dir ? 63 - _r : _r)) * 1024 + h * 128; \
            fraw[jj] = *(const unsigned*)(Fq + _g + 2 * lane); \
            if ((i) >= 4) qraw[jj] = *(const unsigned*)(Qb + _g + 2 * lane); \
            vraw[jj] = Vb[_g + vs * 64 + lane]; } } while (0)
        GLA_LOAD(0);
        for (int i = 0; i < 36; ++i) {
            const bool has_out = i >= 4;
            float f0[8], f1[8], p0[8], p1[8]; float run0 = 1.f, run1 = 1.f;
#pragma unroll
            for (int jj = 0; jj < 8; ++jj) { f0[jj] = (float)(fraw[jj] & 0xffffu) * (1.f / 65535.f); f1[jj] = (float)(fraw[jj] >> 16) * (1.f / 65535.f);
                run0 *= f0[jj]; run1 *= f1[jj]; p0[jj] = run0; p1[jj] = run1; }
            *(LAS f32x2*)(TOT + w * 128 + 2 * lane) = (f32x2){run0, run1};
            __syncthreads();
            float pre0 = 1.f, pre1 = 1.f, mid0 = 1.f, mid1 = 1.f;
#pragma unroll
            for (int j = 0; j < 8; ++j) { const f32x2 t = *(const LAS f32x2*)(TOT + j * 128 + 2 * lane);
                pre0 *= (j < w) ? t.x : 1.f; pre1 *= (j < w) ? t.y : 1.f; if (j < 4) { mid0 *= t.x; mid1 *= t.y; } }
            const float rmid0 = fast_rcp(mid0), rmid1 = fast_rcp(mid1);
            unsigned kt0[4], kt1[4];
#pragma unroll
            for (int jj = 0; jj < 8; jj += 2) {
                float ka[2], kb[2];
#pragma unroll
                for (int e = 0; e < 2; ++e) { const int j2 = jj + e;
                    const float pc0 = p0[j2] * pre0, pc1 = p1[j2] * pre1;
                    const float ks0 = (1.f - f0[j2]) * mid0 * fast_rcp(pc0), ks1 = (1.f - f1[j2]) * mid1 * fast_rcp(pc1);
                    ka[e] = ks0; kb[e] = ks1;
                    if (has_out) {
                        *(LAS unsigned*)(KS + (8 * w + j2) * 272 + 4 * lane) = pk2(ks0, ks1);
                        const float qs0 = bflo(qraw[j2]) * pc0 * rmid0, qs1 = bfhi(qraw[j2]) * pc1 * rmid1;
                        *(LAS unsigned*)(QS + (8 * w + j2) * 272 + 4 * lane) = pk2(qs0, qs1); } }
                kt0[jj >> 1] = pk2(ka[0], ka[1]); kt1[jj >> 1] = pk2(kb[0], kb[1]); }
            *(LAS v4u*)(KST + (2 * lane) * 144 + 16 * w) = (v4u){kt0[0], kt0[1], kt0[2], kt0[3]};
            *(LAS v4u*)(KST + (2 * lane + 1) * 144 + 16 * w) = (v4u){kt1[0], kt1[1], kt1[2], kt1[3]};
            *(LAS v4u*)(VT + lane * 144 + 16 * w) = (v4u){vraw[0] | (vraw[1] << 16), vraw[2] | (vraw[3] << 16), vraw[4] | (vraw[5] << 16), vraw[6] | (vraw[7] << 16)};
            f32x4 pm4 = (f32x4){1.f, 1.f, 1.f, 1.f}, pl4 = pm4;
#pragma unroll
            for (int j = 0; j < 8; ++j) { const f32x4 t = *(const LAS f32x4*)(TOT + j * 128 + 16 * w + 4 * fq); pl4 *= t; if (j < 4) pm4 *= t; }
            if (has_out) {
#pragma unroll
                for (int vb = 0; vb < 4; ++vb) { const f32x4 sp = pm4 * S[vb];
                    *(LAS v2u*)(SPT + (16 * vb + fr) * 272 + (16 * w + 4 * fq) * 2) = (v2u){pk2(sp[0], sp[1]), pk2(sp[2], sp[3])}; } }
            if (i + 1 < 36) GLA_LOAD(i + 1);
            __syncthreads();
            if (has_out) {
                bf16x8 qf[4];
#pragma unroll
                for (int kk = 0; kk < 4; ++kk) qf[kk] = *(const LAS bf16x8*)(QS + (16 * ci + fr) * 272 + (32 * kk + 8 * fq) * 2);
                f32x4 at[4];
#pragma unroll
                for (int sb = 0; sb < 4; ++sb) { at[sb] = (f32x4){0.f, 0.f, 0.f, 0.f};
                    if (sb <= ci) {
#pragma unroll
                        for (int kk = 0; kk < 4; ++kk) { const bf16x8 kf = *(const LAS bf16x8*)(KS + (16 * sb + fr) * 272 + (32 * kk + 8 * fq) * 2); at[sb] = mfma16(kf, qf[kk], at[sb]); }
                        if (sb == ci) {
#pragma unroll
                            for (int jj = 0; jj < 4; ++jj) at[sb][jj] = (4 * fq + jj <= fr) ? at[sb][jj] : 0.f; } } }
                f32x4 oacc[2]; oacc[0] = (f32x4){0.f, 0.f, 0.f, 0.f}; oacc[1] = oacc[0];
#pragma unroll
                for (int k2 = 0; k2 < 2; ++k2) {
                    if (2 * k2 <= ci) {
                        const bf16x8 pb = as_bf16x8((v4u){pk2(at[2 * k2][0], at[2 * k2][1]), pk2(at[2 * k2][2], at[2 * k2][3]), pk2(at[2 * k2 + 1][0], at[2 * k2 + 1][1]), pk2(at[2 * k2 + 1][2], at[2 * k2 + 1][3])});
#pragma unroll
                        for (int vt = 0; vt < 2; ++vt) { const LAS unsigned char* vp = VT + (16 * (2 * vh + vt) + fr) * 144 + (32 * k2 + 4 * fq) * 2;
                            const v2u lo = *(const LAS v2u*)vp, hi = *(const LAS v2u*)(vp + 32);
                            oacc[vt] = mfma16(as_bf16x8((v4u){lo[0], lo[1], hi[0], hi[1]}), pb, oacc[vt]); } } }
#pragma unroll
                for (int kk = 0; kk < 4; ++kk)
#pragma unroll
                    for (int vt = 0; vt < 2; ++vt) { const bf16x8 sf = *(const LAS bf16x8*)(SPT + (16 * (2 * vh + vt) + fr) * 272 + (32 * kk + 8 * fq) * 2); oacc[vt] = mfma16(sf, qf[kk], oacc[vt]); }
                const int r = 16 * ci + fr; const size_t go = (size_t)(GLA_ROWBASE(i) + (dir ? 63 - r : r)) * 1024 + h * 128 + vs * 64 + 4 * fq;
#pragma unroll
                for (int vt = 0; vt < 2; ++vt) *(f32x4*)(O + go + 16 * (2 * vh + vt)) = oacc[vt];
            }
            {
                bf16x8 ka[2];
#pragma unroll
                for (int ss = 0; ss < 2; ++ss) ka[ss] = *(const LAS bf16x8*)(KST + (16 * w + fr) * 144 + (32 * ss + 8 * fq) * 2);
                f32x4 sc;
#pragma unroll
                for (int e = 0; e < 4; ++e) sc[e] = pl4[e] * fast_rcp(pm4[e]);
#pragma unroll
                for (int vb = 0; vb < 4; ++vb) { f32x4 uu = (f32x4){0.f, 0.f, 0.f, 0.f};
#pragma unroll
                    for (int ss = 0; ss < 2; ++ss) { const bf16x8 vf = *(const LAS bf16x8*)(VT + (16 * vb + fr) * 144 + (32 * ss + 8 * fq) * 2); uu = mfma16(ka[ss], vf, uu); }
                    S[vb] = pl4 * S[vb] + sc * uu; }
            }
        }
        __syncthreads();
#undef GLA_LOAD
#undef GLA_ROWBASE
    }
}

__global__ void __launch_bounds__(512, 2) mega_fwd(Args a) {
    extern __shared__ __attribute__((aligned(16))) unsigned char lds_raw[];
    LAS unsigned char* lds = (LAS unsigned char*)lds_raw;
    const int lo = karg_i32(144), hi = karg_i32(148);
    const int wave_s = __builtin_amdgcn_readfirstlane(threadIdx.x >> 6);
#define IN(k) (lo <= (k) && (k) < hi)
#define SEAM(k) do { if (IN(k) && IN((k) + 1)) cg::this_grid().sync(); } while (0)
    unsigned char* ws = KA_WS();
    if (IN(0)) { phase_prologue(a, lds, wave_s); } SEAM(0);
    if (IN(1)) { phase_modnorm(a, 0, KA_IN(0), MT, (bf16*)KA_OUT(), wave_s); } SEAM(1);
    if (IN(2)) {
        EpiInProj E{ws, 0};
        { pg8::Gemm g{(const bf16*)KA_OUT(), (const bf16*)(ws + WS_W0T), MT, 5120, 1024, 1024, 1024, 0}; pg8::StaticOrder S; S.init(MT, 5120, gridDim.x, blockIdx.x);
          pg8::gemm_phase<EpiInProj, pg8::StaticOrder>(lds, g, S, E, wave_s); }
        E.row_off = MT;
        { pg8::Gemm g{(const bf16*)KA_OUT() + (size_t)MT * 1024, (const bf16*)(ws + WS_W0T), MC, 3072, 1024, 1024, 1024, 0}; pg8::StaticOrder S; S.init(MC, 3072, gridDim.x, blockIdx.x);
          pg8::gemm_phase<EpiInProj, pg8::StaticOrder>(lds, g, S, E, wave_s); }
    } SEAM(2);
    if (IN(3)) { phase_gla(a, lds, wave_s); } SEAM(3);
    if (IN(4)) { phase_headnorm(a, wave_s); } SEAM(4);
    if (IN(5)) {
        EpiResid E{KA_IN(0), (float*)(ws + WS_X1), (const float*)(ws + WS_MOD) + 2048};
        pg8::Gemm g{(const bf16*)(ws + WS_A1), (const bf16*)(ws + WS_W1T), MT, 1024, 1024, 1024, 1024, 0}; pg8::StaticOrder S; S.init(MT, 1024, gridDim.x, blockIdx.x);
        pg8::gemm_phase<EpiResid, pg8::StaticOrder>(lds, g, S, E, wave_s);
    } SEAM(5);
    if (IN(6)) { phase_modnorm(a, 1, (const float*)(ws + WS_X1), MT, (bf16*)(ws + WS_A2), wave_s); } SEAM(6);
    if (IN(7)) {
        EpiPoolIn E{(float*)(ws + WS_U), (bf16*)(ws + WS_ZP)};
        pg8::Gemm g{(const bf16*)(ws + WS_A2), (const bf16*)(ws + WS_W2T), MT, 2048, 1024, 1024, 1024, 0}; pg8::StaticOrder S; S.init(MT, 2048, gridDim.x, blockIdx.x);
        pg8::gemm_phase<EpiPoolIn, pg8::StaticOrder>(lds, g, S, E, wave_s);
    } SEAM(7);
    if (IN(8)) { phase_pool(a, lds, wave_s); } SEAM(8);
    if (IN(9)) {
        EpiGrp E{(bf16*)(ws + WS_A4), KA_IN(13), (const bf16*)(ws + WS_ZP)};
        pg8::Gemm g{(const bf16*)(ws + WS_A3), (const bf16*)(ws + WS_WGT), MT, 1024, 256, 1024, 256, 512}; pg8::StaticOrder S; S.init(MT, 1024, gridDim.x, blockIdx.x);
        pg8::gemm_phase<EpiGrp, pg8::StaticOrder>(lds, g, S, E, wave_s);
    } SEAM(9);
    if (IN(10)) {
        EpiResid E{(const float*)(ws + WS_X1), KA_OUT(), (const float*)(ws + WS_MOD) + 9 * 3072 + 2048};
        pg8::Gemm g{(const bf16*)(ws + WS_A4), (const bf16*)(ws + WS_W3T), MT, 1024, 1024, 1024, 1024, 0}; pg8::StaticOrder S; S.init(MT, 1024, gridDim.x, blockIdx.x);
        pg8::gemm_phase<EpiResid, pg8::StaticOrder>(lds, g, S, E, wave_s);
    } SEAM(10);
    if (IN(11)) { phase_final(a, wave_s); }
#undef IN
#undef SEAM
}

extern "C" void kernel_launch(void* const* d_in, const int* in_sizes, int n_in, void* d_out, int out_size, void* d_ws, size_t ws_size, hipStream_t stream) {
    static int grid = 0;
    if (grid == 0) {
        if (n_in != 16 || out_size != MT * D || ws_size < WS_END) { fprintf(stderr, "kernel_launch: unexpected shapes (n_in %d out %d ws %zu)\n", n_in, out_size, ws_size); grid = -1; return; }
        int dev = 0, cus = 0, per_cu = 0;
        (void)hipGetDevice(&dev); (void)hipDeviceGetAttribute(&cus, hipDeviceAttributeMultiprocessorCount, dev);
        if (hipFuncSetAttribute((const void*)mega_fwd, hipFuncAttributeMaxDynamicSharedMemorySize, LDS_BYTES) != hipSuccess) fprintf(stderr, "kernel_launch: hipFuncSetAttribute failed\n");
        if (hipOccupancyMaxActiveBlocksPerMultiprocessor(&per_cu, (const void*)mega_fwd, 512, LDS_BYTES) != hipSuccess || per_cu < 1) { fprintf(stderr, "kernel_launch: occupancy query gave %d\n", per_cu); per_cu = 1; }
        (void)hipGetLastError();
        grid = cus * per_cu;
        fprintf(stderr, "kernel_launch: grid %d (cus %d x %d)\n", grid, cus, per_cu);
    }
    if (grid < 0) return;
    Args a{};
    for (int i = 0; i < 16; ++i) a.in[i] = (const float*)d_in[i];
    a.out = (float*)d_out; a.ws = (unsigned char*)d_ws;
#if MK_N_LAUNCHES == 1
    a.ph_lo = 0; a.ph_hi = NPHASE;
    void* args[] = {&a};
    hipError_t e = hipLaunchCooperativeKernel((const void*)mega_fwd, dim3(grid), dim3(512), args, LDS_BYTES, stream);
    if (e != hipSuccess) fprintf(stderr, "kernel_launch: cooperative launch failed: %s (grid %d)\n", hipGetErrorString(e), grid);
#else
    for (int ph = 0; ph < NPHASE; ++ph) { a.ph_lo = ph; a.ph_hi = ph + 1; hipLaunchKernelGGL(mega_fwd, dim3(grid), dim3(512), LDS_BYTES, stream, a); }
#endif
}
```

```cpp
#include <hip/hip_runtime.h>
#include <hip/hip_cooperative_groups.h>
#include <cstdio>
#include <cstdint>
namespace cg = cooperative_groups;
#ifndef MK_N_LAUNCHES
#define MK_N_LAUNCHES 1
#define PROBE_MASK 0
#endif
namespace pg8 {
#define PG8_LAS __attribute__((address_space(3)))
typedef unsigned short bf16_t;
typedef short bf16x8 __attribute__((ext_vector_type(8)));
typedef float f32x4 __attribute__((ext_vector_type(4)));
typedef unsigned u32x4 __attribute__((ext_vector_type(4)));
constexpr int BM = 256, BK = 64, HALF = 128, HTB = HALF * BK * 2  , STAGE_BYTES = 8 * HTB, NXCD = 8, WGM = 8;

__host__ __device__ __forceinline__ int lds_byte(int r, int c) { const int st = (r >> 4) * 2 + (c >> 5), rr = r & 15, cc = c & 31, ob = rr * 64 + cc * 2; return st * 1024 + (ob ^ (((ob >> 9) & 1) << 5)); }
__host__ __device__ __forceinline__ void stage_rc(int b, int& R, int& C) { const int st = b / 1024, sb = b % 1024, swz = sb ^ (((sb >> 9) & 1) << 5); R = (st >> 1) * 16 + swz / 64; C = (st & 1) * 32 + (swz % 64) / 2; }
__host__ __device__ __forceinline__ int perm32(int rho) { const int n = rho >> 4, i = rho & 15; return 8 * (i >> 2) + 4 * n + (i & 3); }

struct Unit { int pm, pn; };
struct Gemm { const bf16_t* A; const bf16_t* Bt; int M, N, K, lda, ldb, a_pn_bytes; };

struct StaticOrder {
    int nM, nN, nwg, G, c;
    __host__ __device__ void init(int M, int N, int G_, int c_) { nM = M / BM; nN = N / BM; nwg = nM * nN; G = G_; c = c_; }
    __host__ __device__ bool next(int i, Unit& u) const {
        const long L = (long)i * G + c; if (L >= nwg) return false;
        int wgid = (int)L; { const int q = nwg / NXCD, r = nwg % NXCD, xcd = wgid % NXCD, off = wgid / NXCD; wgid = (xcd < r ? xcd * (q + 1) : r * (q + 1) + (xcd - r) * q) + off; }
        const int nig = WGM * nN, gid = wgid / nig, fm = gid * WGM, gsz = (nM - fm) < WGM ? (nM - fm) : WGM;
        u.pm = fm + ((wgid % nig) % gsz); u.pn = (wgid % nig) / gsz; return true;
    }
    __device__ __forceinline__ void a_ready(const Unit&) const {}
    __device__ __forceinline__ void done(const Unit&) const {}
};

template <class Epi, class Sched>
__device__ __forceinline__ void gemm_phase(PG8_LAS unsigned char* lds, const Gemm g, const Sched& S, const Epi& E, const int wave_s) {
    int tid_ = wave_s * 64 + (int)__builtin_amdgcn_mbcnt_hi(~0u, __builtin_amdgcn_mbcnt_lo(~0u, 0u)); const int tid = tid_, wid = __builtin_amdgcn_readfirstlane(tid >> 6), lane = tid & 63, wr = wid >> 2, wc = wid & 3, fr = lane & 15, fq = lane >> 4;
    const int K = g.K, nt = K / BK;
    unsigned voffA[2], voffB[2];
#pragma unroll
    for (int i = 0; i < 2; ++i) { int R, C; stage_rc(tid * 16 + i * 8192, R, C); const int Rb = Epi::PERM ? ((R & ~31) + perm32(R & 31)) : R;
        voffA[i] = (unsigned)(R * g.lda + C) * 2u; voffB[i] = (unsigned)(Rb * g.ldb + C) * 2u; }
    const size_t kstep = (size_t)(BK * 2);
    const size_t hstepA = (size_t)HALF * g.lda * 2, hstepB = (size_t)HALF * g.ldb * 2;
    const size_t tstepA = 2 * hstepA, tstepB = 2 * hstepB;
    const unsigned ldsw = (unsigned)wid * 1024u;
    const int aoff = lds_byte(wr * 64 + fr, fq * 8), boff = lds_byte(wc * 32 + fr, fq * 8);
#define PG8_SA(b, h) (((b) * 2 + (h)) * HTB)
#define PG8_SB(b, h) ((4 + (b) * 2 + (h)) * HTB)
#define PG8_STAGE(bufoff, gbase, voff) do { _Pragma("unroll") for (int _i = 0; _i < 2; ++_i) \
        __builtin_amdgcn_global_load_lds((const unsigned*)((const char*)(gbase) + (voff)[_i]), (PG8_LAS unsigned*)(lds + (bufoff) + ldsw + _i * 8192), 16, 0, 0); } while (0)
#define PG8_LDA(dst, b, h) do { _Pragma("unroll") for (int m = 0; m < 4; ++m) _Pragma("unroll") for (int k = 0; k < 2; ++k) dst[m][k] = *(const PG8_LAS bf16x8*)(lds + PG8_SA(b, h) + aoff + m * 2048 + k * 1024); } while (0)
#define PG8_LDB(dst, b, h) do { _Pragma("unroll") for (int n = 0; n < 2; ++n) _Pragma("unroll") for (int k = 0; k < 2; ++k) dst[n][k] = *(const PG8_LAS bf16x8*)(lds + PG8_SB(b, h) + boff + n * 2048 + k * 1024); } while (0)
#define PG8_MMA(ai, bj, At, Bt) do { __builtin_amdgcn_s_setprio(1); _Pragma("unroll") for (int m = 0; m < 4; ++m) _Pragma("unroll") for (int n = 0; n < 2; ++n) _Pragma("unroll") for (int k = 0; k < 2; ++k) \
        acc[ai][bj][m][n] = __builtin_amdgcn_mfma_f32_16x16x32_bf16(Bt[n][k], At[m][k], acc[ai][bj][m][n], 0, 0, 0); __builtin_amdgcn_s_setprio(0); } while (0)
#define PG8_WAIT_V(n) asm volatile("s_waitcnt vmcnt(" #n ")" ::: "memory")
#define PG8_WAIT_L(n) asm volatile("s_waitcnt lgkmcnt(" #n ")" ::: "memory")
#define PG8_BAR __builtin_amdgcn_s_barrier()
#define PG8_SCHED __builtin_amdgcn_sched_barrier(0)
    Unit cur, nxt; int ui = 0;
    if (!S.next(0, cur)) return;
    f32x4 acc[2][2][4][2];
#pragma unroll
    for (int a = 0; a < 2; ++a)
#pragma unroll
        for (int b = 0; b < 2; ++b)
#pragma unroll
            for (int m = 0; m < 4; ++m)
#pragma unroll
                for (int n = 0; n < 2; ++n) acc[a][b][m][n] = (f32x4){0.f, 0.f, 0.f, 0.f};
    bf16x8 At[4][2], B0[2][2], B1[2][2];
    const char* cA = (const char*)g.A + (size_t)cur.pm * tstepA + (size_t)cur.pn * g.a_pn_bytes; const char* cB = (const char*)g.Bt + (size_t)cur.pn * tstepB;
    S.a_ready(cur);
    PG8_STAGE(PG8_SB(0, 0), cB, voffB); PG8_STAGE(PG8_SA(0, 0), cA, voffA); PG8_STAGE(PG8_SB(0, 1), cB + hstepB, voffB); PG8_STAGE(PG8_SA(0, 1), cA + hstepA, voffA);
    if (wr == 1) PG8_BAR;
    PG8_WAIT_V(4); PG8_BAR;
    PG8_STAGE(PG8_SB(1, 0), cB + kstep, voffB); PG8_STAGE(PG8_SA(1, 0), cA + kstep, voffA); PG8_STAGE(PG8_SB(1, 1), cB + hstepB + kstep, voffB);
    PG8_WAIT_V(6); PG8_BAR;
    for (;;) {
        const bool has_next = S.next(ui + 1, nxt);
        const char* nA = has_next ? (const char*)g.A + (size_t)nxt.pm * tstepA + (size_t)nxt.pn * g.a_pn_bytes : cA; const char* nB = has_next ? (const char*)g.Bt + (size_t)nxt.pn * tstepB : cB;
        for (int t = 0; t < nt; t += 2) {
            const bool last = (t == nt - 2);
            const char* a1 = cA + (size_t)(t + 1) * kstep;
            const char* a2 = last ? nA : cA + (size_t)(t + 2) * kstep; const char* b2 = last ? nB : cB + (size_t)(t + 2) * kstep;
            const char* a3 = a2 + kstep; const char* b3 = b2 + kstep;
            if (last && has_next) S.a_ready(nxt);
            PG8_LDB(B0, 0, 0); PG8_SCHED; PG8_LDA(At, 0, 0); PG8_STAGE(PG8_SA(1, 1), a1 + hstepA, voffA);
            PG8_WAIT_L(8); PG8_BAR; PG8_WAIT_L(0); PG8_MMA(0, 0, At, B0); PG8_BAR; PG8_SCHED;
            PG8_LDB(B1, 0, 1); PG8_STAGE(PG8_SB(0, 0), b2, voffB);
            PG8_BAR; PG8_WAIT_L(0); PG8_MMA(0, 1, At, B1); PG8_BAR;
            PG8_LDA(At, 0, 1); PG8_STAGE(PG8_SA(0, 0), a2, voffA);
            PG8_BAR; PG8_WAIT_L(0); PG8_MMA(1, 0, At, B0); PG8_BAR; PG8_SCHED;
            PG8_STAGE(PG8_SB(0, 1), b2 + hstepB, voffB);
            PG8_WAIT_V(6); PG8_BAR; PG8_MMA(1, 1, At, B1); PG8_BAR;
            PG8_LDB(B0, 1, 0); PG8_SCHED; PG8_LDA(At, 1, 0); PG8_STAGE(PG8_SA(0, 1), a2 + hstepA, voffA);
            PG8_WAIT_L(8); PG8_BAR; PG8_WAIT_L(0); PG8_MMA(0, 0, At, B0); PG8_BAR; PG8_SCHED;
            PG8_LDB(B1, 1, 1); PG8_STAGE(PG8_SB(1, 0), b3, voffB);
            PG8_BAR; PG8_WAIT_L(0); PG8_MMA(0, 1, At, B1); PG8_BAR;
            PG8_LDA(At, 1, 1); PG8_STAGE(PG8_SA(1, 0), a3, voffA);
            PG8_BAR; PG8_WAIT_L(0); PG8_MMA(1, 0, At, B0); PG8_BAR; PG8_SCHED;
            PG8_STAGE(PG8_SB(1, 1), b3 + hstepB, voffB);
            PG8_WAIT_V(6); PG8_BAR; PG8_MMA(1, 1, At, B1); PG8_BAR;
        }
        if constexpr (!Epi::AFTER_DRAIN) { E(acc, cur, wr, wc, fr, fq); S.done(cur); }
        if (!has_next) break;
#pragma unroll
        for (int a = 0; a < 2; ++a)
#pragma unroll
            for (int b = 0; b < 2; ++b)
#pragma unroll
                for (int m = 0; m < 4; ++m)
#pragma unroll
                    for (int n = 0; n < 2; ++n) acc[a][b][m][n] = (f32x4){0.f, 0.f, 0.f, 0.f};
        cur = nxt; cA = nA; cB = nB; ++ui;
    }
    PG8_WAIT_V(0);
    if (wr == 0) PG8_BAR;
    PG8_BAR;
    if constexpr (Epi::AFTER_DRAIN) { E.fused(acc, cur, wr, wc, fr, fq, lds, wid, lane); S.done(cur); }
#undef PG8_SA
#undef PG8_SB
#undef PG8_STAGE
#undef PG8_LDA
#undef PG8_LDB
#undef PG8_MMA
#undef PG8_WAIT_V
#undef PG8_WAIT_L
#undef PG8_BAR
#undef PG8_SCHED
}
}

constexpr int BATCH = 8, SEQ = 2048, D = 1024, CTX = 256;
constexpr int MT = BATCH * SEQ;
constexpr int MC = BATCH * CTX;
constexpr int MA = MT + MC;
constexpr float EPS = 1e-6f;
constexpr int NPHASE = 12;
constexpr size_t MiB = 1u << 20;
constexpr size_t WS_MOD = 0;
constexpr size_t WS_LB = 512 * 1024;
constexpr size_t WS_BAR = 768 * 1024;
constexpr size_t WS_W0T = 1 * MiB;
constexpr size_t WS_W1T = 11 * MiB;
constexpr size_t WS_W2T = 13 * MiB;
constexpr size_t WS_WGT = 17 * MiB;
constexpr size_t WS_W3T = 18 * MiB;
constexpr size_t WS_FF = 20 * MiB;
constexpr size_t WS_FB = 56 * MiB;
constexpr size_t WS_V = 92 * MiB;
constexpr size_t WS_Q = 128 * MiB;
constexpr size_t WS_Z = 160 * MiB;
constexpr size_t WS_OB = 192 * MiB;
constexpr size_t WS_A1 = 20 * MiB;
constexpr size_t WS_X1 = 64 * MiB;
constexpr size_t WS_A2 = 128 * MiB;
constexpr size_t WS_U = 192 * MiB;
constexpr size_t WS_ZP = 160 * MiB;
constexpr size_t WS_A3 = 20 * MiB;
constexpr size_t WS_A4 = 128 * MiB;
constexpr size_t WS_PART = 52 * MiB;
constexpr size_t WS_END = 256 * MiB;
constexpr int BAR_CNT_WORD0 = 4096;
constexpr int BAR_BYTES = (4096 + 2 * 4096) * 4;

constexpr int LDS_BYTES = 131072 + 64;
constexpr int LDS_ST_OFF = 131072;

#define LAS __attribute__((address_space(3)))
typedef unsigned short bf16;
typedef unsigned v4u __attribute__((ext_vector_type(4)));
typedef unsigned v2u __attribute__((ext_vector_type(2)));
typedef float f32x4 __attribute__((ext_vector_type(4)));
typedef float f32x2 __attribute__((ext_vector_type(2)));
typedef short bf16x8 __attribute__((ext_vector_type(8)));
#define LDS_WAIT() asm volatile("s_waitcnt lgkmcnt(0)" ::: "memory")

typedef __bf16 bf16x2_t __attribute__((ext_vector_type(2)));
__device__ __forceinline__ unsigned pk2(float lo, float hi) { const bf16x2_t r = __builtin_convertvector((f32x2){lo, hi}, bf16x2_t); return __builtin_bit_cast(unsigned, r); }
__device__ __forceinline__ float bflo(unsigned u) { return __builtin_bit_cast(float, u << 16); }
__device__ __forceinline__ float bfhi(unsigned u) { return __builtin_bit_cast(float, u & 0xffff0000u); }
__device__ __forceinline__ float fast_rcp(float x) { return __builtin_amdgcn_rcpf(x); }
__device__ __forceinline__ float sigmoidf_(float x) { return fast_rcp(1.f + __expf(-x)); }
__device__ __forceinline__ float siluf_(float x) { return x * sigmoidf_(x); }
__device__ __forceinline__ float wave_sum(float v) {
#pragma unroll
    for (int o = 1; o < 64; o <<= 1) v += __shfl_xor(v, o);
    return v;
}


#define XB_TMO      128
#define XB_XCNT(j)  (256  + 64 * (j))
#define XB_XSUB(j)  (1280 + 64 * (j))
#define XB_XGEN(j)  (2304 + 64 * (j))
#define XB_TOP      3328
#define XB_TOPGEN   3392
#define XCD_BAR_WORDS 3456
#define XB_SPIN_CAP (1u << 18)
__device__ __forceinline__ unsigned xb_ld(unsigned* p)              { return __hip_atomic_load(p, __ATOMIC_RELAXED, __HIP_MEMORY_SCOPE_AGENT); }
__device__ __forceinline__ unsigned xb_add(unsigned* p, unsigned v) { return __hip_atomic_fetch_add(p, v, __ATOMIC_RELAXED, __HIP_MEMORY_SCOPE_AGENT); }
__device__ __forceinline__ unsigned xb_xcc_id() { return (unsigned)__builtin_amdgcn_s_getreg((3 << 11) | 20) & 0xFu; }
#define XB_SPIN(cond, bar) do { unsigned _sp = 0; while (cond) { __builtin_amdgcn_s_sleep(1); \
    if ((++_sp & 255u) == 0u) { if (xb_ld(&(bar)[XB_TMO])) break; if (_sp > XB_SPIN_CAP) { atomicAdd(&(bar)[XB_TMO], 1u); break; } } } } while (0)
__device__ __forceinline__ void xcd_barrier_complete(unsigned* bar, unsigned x, unsigned& nloc, unsigned& nx) {
    const unsigned G = gridDim.x * gridDim.y * gridDim.z;
    unsigned sum, cnt, mine, sp = 0u;
    for (;;) {
        sum = 0u; cnt = 0u; mine = 0u;
#pragma unroll
        for (unsigned j = 0; j < 16; ++j) { const unsigned c = xb_ld(&bar[XB_XCNT(j)]); sum += c; cnt += (c > 0u) ? 1u : 0u; mine = (j == x) ? c : mine; }
        if (sum == G) break;
        __builtin_amdgcn_s_sleep(1);
        if ((++sp & 255u) == 0u) { if (xb_ld(&bar[XB_TMO])) break; if (sp > XB_SPIN_CAP) { atomicAdd(&bar[XB_TMO], 1u); break; } }
    }
    nloc = mine > 0u ? mine : 1u; nx = cnt > 0u ? cnt : 1u;
}
__device__ __forceinline__ void xcd_barrier(unsigned* bar, volatile LAS unsigned* st, const bool leader) {
    asm volatile("s_waitcnt vmcnt(0)" ::: "memory");
    __syncthreads();
    if (leader) {
        const unsigned x = xb_xcc_id();
        __builtin_amdgcn_s_waitcnt(0);
        unsigned nloc = st[0], nx = st[1];
        if (nloc == 0u) { xcd_barrier_complete(bar, x, nloc, nx); st[0] = nloc; st[1] = nx; }
        const unsigned old = xb_add(&bar[XB_XSUB(x)], 1u);
        const unsigned gen = old / nloc;
        if (old + 1u == (gen + 1u) * nloc) {
            __builtin_amdgcn_fence(__ATOMIC_RELEASE, "agent");
            asm volatile("s_waitcnt vmcnt(0)" ::: "memory");
            const unsigned og = xb_add(&bar[XB_TOP], 1u);
            const unsigned tg = og / nx;
            if (og + 1u == (tg + 1u) * nx) xb_add(&bar[XB_TOPGEN], 1u);
            else XB_SPIN(xb_ld(&bar[XB_TOPGEN]) == tg, bar);
            __builtin_amdgcn_fence(__ATOMIC_ACQUIRE, "agent");
            xb_add(&bar[XB_XGEN(x)], 1u);
            asm volatile("s_waitcnt vmcnt(0)" ::: "memory");
        } else {
            XB_SPIN(xb_ld(&bar[XB_XGEN(x)]) == gen, bar);
            __builtin_amdgcn_fence(__ATOMIC_ACQUIRE, "agent");
            asm volatile("s_waitcnt vmcnt(0)" ::: "memory");
        }
    }
    __syncthreads();
}

struct Args { const float* in[16]; float* out; unsigned char* ws; int ph_lo, ph_hi; };
#define GAS __attribute__((address_space(1)))
#define CAS __attribute__((address_space(4)))
__device__ __forceinline__ const unsigned char CAS* karg_base() { const unsigned char CAS* p = (const unsigned char CAS*)__builtin_amdgcn_kernarg_segment_ptr(); asm volatile("" : "+s"(p)); return p; }
__device__ __forceinline__ unsigned long long karg_u64(int off) { return *(const unsigned long long CAS*)(karg_base() + off); }
__device__ __forceinline__ int karg_i32(int off) { return *(const int CAS*)(karg_base() + off); }
#define KA_IN(i) ((const float*)(const float GAS*)karg_u64(8 * (i)))
#define KA_OUT() ((float*)(float GAS*)karg_u64(128))
#define KA_WS() ((unsigned char*)(unsigned char GAS*)karg_u64(136))
static_assert(sizeof(Args) == 152, "Args layout");

struct EpiInProj {
    static constexpr bool PERM = true, AFTER_DRAIN = false;
    unsigned char* ws; int row_off;
    __device__ __forceinline__ void operator()(const f32x4 (&acc)[2][2][4][2], const pg8::Unit& u, int wr, int wc, int fr, int fq) const {
        const int type = u.pn >> 2, colt = (u.pn & 3) * 256;
        const int row0 = row_off + u.pm * 256 + wr * 64 + fr, col0 = colt + wc * 32 + 8 * fq;
        if (type < 2) {
            bf16* F = (bf16*)(ws + (type == 0 ? WS_FF : WS_FB)); const float* lbp = (const float*)(ws + WS_LB) + type * 1024 + col0;
            f32x4 lv[2][2];
#pragma unroll
            for (int bj = 0; bj < 2; ++bj)
#pragma unroll
                for (int n = 0; n < 2; ++n) lv[bj][n] = *(const f32x4*)(lbp + bj * 128 + 4 * n);
#pragma unroll
            for (int ai = 0; ai < 2; ++ai)
#pragma unroll
                for (int m = 0; m < 4; ++m) { bf16* rowp = F + (size_t)(row0 + ai * 128 + m * 16) * 1024 + col0;
#pragma unroll
                    for (int bj = 0; bj < 2; ++bj) { unsigned o[4];
#pragma unroll
                        for (int n = 0; n < 2; ++n) { float q[4];
#pragma unroll
                            for (int e = 0; e < 4; ++e) { const float l = lv[bj][n][e]; const float f = l + (1.f - l) * sigmoidf_(acc[ai][bj][m][n][e]);
                                q[e] = __builtin_rintf(f * 65535.f); }
                            o[2 * n] = (unsigned)q[0] | ((unsigned)q[1] << 16); o[2 * n + 1] = (unsigned)q[2] | ((unsigned)q[3] << 16); }
                        *(v4u*)(rowp + bj * 128) = (v4u){o[0], o[1], o[2], o[3]}; } }
        } else {
            bf16* O = (bf16*)(ws + (type == 2 ? WS_V : (type == 3 ? WS_Q : WS_Z)));
            const float qs = type == 3 ? 0.08838834764831845f : 1.f;
#pragma unroll
            for (int ai = 0; ai < 2; ++ai)
#pragma unroll
                for (int m = 0; m < 4; ++m) { bf16* rowp = O + (size_t)(row0 + ai * 128 + m * 16) * 1024 + col0;
#pragma unroll
                    for (int bj = 0; bj < 2; ++bj) { f32x4 v0 = acc[ai][bj][m][0], v1 = acc[ai][bj][m][1];
                        if (type >= 3) {
#pragma unroll
                            for (int e = 0; e < 4; ++e) { v0[e] = siluf_(v0[e]) * qs; v1[e] = siluf_(v1[e]) * qs; } }
                        *(v4u*)(rowp + bj * 128) = (v4u){pk2(v0[0], v0[1]), pk2(v0[2], v0[3]), pk2(v1[0], v1[1]), pk2(v1[2], v1[3])}; } }
        }
    }
};
struct EpiResid {
    static constexpr bool PERM = false, AFTER_DRAIN = false;
    const float* xin; float* out; const float* gate;
    __device__ __forceinline__ void operator()(const f32x4 (&acc)[2][2][4][2], const pg8::Unit& u, int wr, int wc, int fr, int fq) const {
        const int row0 = u.pm * 256 + wr * 64 + fr, col0 = u.pn * 256 + wc * 32 + 4 * fq;
        const float* gp = gate + (size_t)(u.pm >> 3) * 3072 + col0;
        f32x4 gv[2][2];
#pragma unroll
        for (int bj = 0; bj < 2; ++bj)
#pragma unroll
            for (int n = 0; n < 2; ++n) gv[bj][n] = *(const f32x4*)(gp + bj * 128 + n * 16);
#pragma unroll
        for (int ai = 0; ai < 2; ++ai)
#pragma unroll
            for (int m = 0; m < 4; ++m) { const size_t ro = (size_t)(row0 + ai * 128 + m * 16) * 1024 + col0;
#pragma unroll
                for (int bj = 0; bj < 2; ++bj)
#pragma unroll
                    for (int n = 0; n < 2; ++n) { const f32x4 xv = *(const f32x4*)(xin + ro + bj * 128 + n * 16);
                        *(f32x4*)(out + ro + bj * 128 + n * 16) = xv + gv[bj][n] * acc[ai][bj][m][n]; } }
    }
};

template <int MODE> struct EpiResidNorm {
    static constexpr bool PERM = true, AFTER_DRAIN = true;
    const void* xin; void* xout; const float* gate; const float* nw; const float* mod; bf16* A2; float* part; unsigned* cnt; unsigned* bar;
    __device__ __forceinline__ void operator()(const f32x4 (&)[2][2][4][2], const pg8::Unit&, int, int, int, int) const {}
    __device__ __forceinline__ void fused(f32x4 (&acc)[2][2][4][2], const pg8::Unit& u, int wr, int wc, int fr, int fq, LAS unsigned char*, int wid, int lane) const {
        const int row0 = u.pm * 256 + wr * 64 + fr, col0 = u.pn * 256 + wc * 32 + 8 * fq;
        const float* gp = gate + (size_t)(u.pm >> 3) * 3072 + col0;
        float ss[2][4];
        f32x4 gv[2][2];
#pragma unroll
        for (int bj = 0; bj < 2; ++bj)
#pragma unroll
            for (int n = 0; n < 2; ++n) gv[bj][n] = *(const f32x4*)(gp + bj * 128 + 4 * n);
#pragma unroll
        for (int ai = 0; ai < 2; ++ai) {
            v4u xb[4][2]; f32x4 xf[4][2][2];
#pragma unroll
            for (int m = 0; m < 4; ++m)
#pragma unroll
                for (int bj = 0; bj < 2; ++bj) { const size_t ro = (size_t)(row0 + ai * 128 + m * 16) * 1024 + col0 + bj * 128;
                    if (MODE == 0) { xf[m][bj][0] = *(const f32x4*)((const float*)xin + ro); xf[m][bj][1] = *(const f32x4*)((const float*)xin + ro + 4); }
                    else xb[m][bj] = *(const v4u*)((const bf16*)xin + ro); }
#pragma unroll
            for (int m = 0; m < 4; ++m) { float s = 0.f;
#pragma unroll
                for (int bj = 0; bj < 2; ++bj) { f32x4 xv[2];
                    if (MODE == 0) { xv[0] = xf[m][bj][0]; xv[1] = xf[m][bj][1]; }
                    else { const v4u q = xb[m][bj]; xv[0] = (f32x4){bflo(q[0]), bfhi(q[0]), bflo(q[1]), bfhi(q[1])}; xv[1] = (f32x4){bflo(q[2]), bfhi(q[2]), bflo(q[3]), bfhi(q[3])}; }
#pragma unroll
                    for (int n = 0; n < 2; ++n) { const f32x4 v = xv[n] + gv[bj][n] * acc[ai][bj][m][n]; acc[ai][bj][m][n] = v; s += (v.x * v.x + v.y * v.y) + (v.z * v.z + v.w * v.w); } }
                s += __shfl_xor(s, 16); s += __shfl_xor(s, 32); ss[ai][m] = s; } }
        if (fq == 0) {
#pragma unroll
            for (int ai = 0; ai < 2; ++ai)
#pragma unroll
                for (int m = 0; m < 4; ++m) __hip_atomic_store((unsigned*)(part + (size_t)(row0 + ai * 128 + m * 16) * 16 + u.pn * 4 + wc), __builtin_bit_cast(unsigned, ss[ai][m]), __ATOMIC_RELAXED, __HIP_MEMORY_SCOPE_AGENT); }
        asm volatile("s_waitcnt vmcnt(0)" ::: "memory");
        __syncthreads();
        if (wid == 0 && lane == 0) (void)xb_add(cnt + 64 * u.pm, 1u);
        if (MODE == 0) {
#pragma unroll
            for (int ai = 0; ai < 2; ++ai)
#pragma unroll
                for (int m = 0; m < 4; ++m)
#pragma unroll
                    for (int bj = 0; bj < 2; ++bj) { const f32x4 v0 = acc[ai][bj][m][0], v1 = acc[ai][bj][m][1];
                        *(v4u*)((bf16*)xout + (size_t)(row0 + ai * 128 + m * 16) * 1024 + col0 + bj * 128) = (v4u){pk2(v0[0], v0[1]), pk2(v0[2], v0[3]), pk2(v1[0], v1[1]), pk2(v1[2], v1[3])}; } }
        if (wid == 0 && lane == 0) { unsigned* cw = cnt + 64 * u.pm; XB_SPIN(xb_ld(cw) < 4u, bar);
            __builtin_amdgcn_fence(__ATOMIC_ACQUIRE, "agent"); asm volatile("s_waitcnt vmcnt(0)" ::: "memory"); }
        __syncthreads();
        float rstd[2][4];
#pragma unroll
        for (int ai = 0; ai < 2; ++ai)
#pragma unroll
            for (int m = 0; m < 4; ++m) { unsigned* pp = (unsigned*)(part + (size_t)(row0 + ai * 128 + m * 16) * 16 + 4 * fq); float s = 0.f;
#pragma unroll
                for (int e = 0; e < 4; ++e) s += __builtin_bit_cast(float, __hip_atomic_load(pp + e, __ATOMIC_RELAXED, __HIP_MEMORY_SCOPE_AGENT));
                s += __shfl_xor(s, 16); s += __shfl_xor(s, 32);
                rstd[ai][m] = __builtin_amdgcn_rsqf(s * (1.f / 1024.f) + EPS); }
        if (MODE == 1) {
#pragma unroll
            for (int bj = 0; bj < 2; ++bj)
#pragma unroll
                for (int n = 0; n < 2; ++n) { const f32x4 w4 = *(const f32x4*)(nw + col0 + bj * 128 + 4 * n);
#pragma unroll
                    for (int ai = 0; ai < 2; ++ai)
#pragma unroll
                        for (int m = 0; m < 4; ++m) *(f32x4*)((float*)xout + (size_t)(row0 + ai * 128 + m * 16) * 1024 + col0 + bj * 128 + 4 * n) = acc[ai][bj][m][n] * rstd[ai][m] * w4; }
        } else {
            const float* mp = mod + (size_t)(u.pm >> 3) * 3072 + col0;
#pragma unroll
            for (int bj = 0; bj < 2; ++bj) { f32x4 g[2], sh[2];
#pragma unroll
                for (int n = 0; n < 2; ++n) { g[n] = *(const f32x4*)(nw + col0 + bj * 128 + 4 * n) * (*(const f32x4*)(mp + 1024 + bj * 128 + 4 * n) + 1.f); sh[n] = *(const f32x4*)(mp + bj * 128 + 4 * n); }
#pragma unroll
                for (int ai = 0; ai < 2; ++ai)
#pragma unroll
                    for (int m = 0; m < 4; ++m) { const f32x4 y0 = acc[ai][bj][m][0] * rstd[ai][m] * g[0] + sh[0], y1 = acc[ai][bj][m][1] * rstd[ai][m] * g[1] + sh[1];
                        *(v4u*)(A2 + (size_t)(row0 + ai * 128 + m * 16) * 1024 + col0 + bj * 128) = (v4u){pk2(y0[0], y0[1]), pk2(y0[2], y0[3]), pk2(y1[0], y1[1]), pk2(y1[2], y1[3])}; } }
        }
    }
};
struct EpiPoolIn {
    static constexpr bool PERM = true, AFTER_DRAIN = false;
    bf16* U; bf16* ZP;
    __device__ __forceinline__ void operator()(const f32x4 (&acc)[2][2][4][2], const pg8::Unit& u, int wr, int wc, int fr, int fq) const {
        const int type = u.pn >> 2, colt = (u.pn & 3) * 256;
        const int row0 = u.pm * 256 + wr * 64 + fr, col0 = colt + wc * 32 + 8 * fq;
#pragma unroll
        for (int ai = 0; ai < 2; ++ai)
#pragma unroll
            for (int m = 0; m < 4; ++m) { const size_t ro = (size_t)(row0 + ai * 128 + m * 16) * 1024 + col0;
#pragma unroll
                for (int bj = 0; bj < 2; ++bj) { f32x4 v0 = acc[ai][bj][m][0], v1 = acc[ai][bj][m][1];
                    if (type == 0) { *(v4u*)(U + ro + bj * 128) = (v4u){pk2(v0[0], v0[1]), pk2(v0[2], v0[3]), pk2(v1[0], v1[1]), pk2(v1[2], v1[3])}; }
                    else {
#pragma unroll
                        for (int e = 0; e < 4; ++e) { v0[e] = siluf_(v0[e]); v1[e] = siluf_(v1[e]); }
                        *(v4u*)(ZP + ro + bj * 128) = (v4u){pk2(v0[0], v0[1]), pk2(v0[2], v0[3]), pk2(v1[0], v1[1]), pk2(v1[2], v1[3])}; } } }
    }
};
struct EpiGrp {
    static constexpr bool PERM = true, AFTER_DRAIN = false;
    bf16* A4; const float* scale; const bf16* ZP;
    __device__ __forceinline__ void operator()(const f32x4 (&acc)[2][2][4][2], const pg8::Unit& u, int wr, int wc, int fr, int fq) const {
        const int row0 = u.pm * 256 + wr * 64 + fr, col0 = u.pn * 256 + wc * 32 + 8 * fq;
#pragma unroll
        for (int ai = 0; ai < 2; ++ai)
#pragma unroll
            for (int m = 0; m < 4; ++m) { const size_t ro = (size_t)(row0 + ai * 128 + m * 16) * 1024 + col0;
#pragma unroll
                for (int bj = 0; bj < 2; ++bj) { const v4u zz = *(const v4u*)(ZP + ro + bj * 128);
                    const f32x4 v0 = acc[ai][bj][m][0] * *(const f32x4*)(scale + col0 + bj * 128), v1 = acc[ai][bj][m][1] * *(const f32x4*)(scale + col0 + bj * 128 + 4);
                    *(v4u*)(A4 + ro + bj * 128) = (v4u){pk2(v0[0] * bflo(zz[0]), v0[1] * bfhi(zz[0])), pk2(v0[2] * bflo(zz[1]), v0[3] * bfhi(zz[1])),
                                                         pk2(v1[0] * bflo(zz[2]), v1[1] * bfhi(zz[2])), pk2(v1[2] * bflo(zz[3]), v1[3] * bfhi(zz[3]))}; } }
    }
};
__device__ __forceinline__ void transpose_item(const float* W, int K, int N, bf16* WT, int row_off, LAS float* scr, int item, int lane) {
    const int nblk = N / 32, kb = item / nblk, nb = item % nblk, k0 = 64 * kb, n0 = 32 * nb;
    float wv[32];
#pragma unroll
    for (int i = 0; i < 32; ++i) wv[i] = W[(size_t)(k0 + 2 * i + (lane >> 5)) * N + n0 + (lane & 31)];
#pragma unroll
    for (int i = 0; i < 32; ++i) scr[(2 * i + (lane >> 5)) * 33 + (lane & 31)] = wv[i];
    LDS_WAIT(); asm volatile("" ::: "memory");
    const int c = lane & 7;
#pragma unroll
    for (int j = 0; j < 4; ++j) { const int n = (lane >> 3) + 8 * j; const LAS float* s = scr + (8 * c) * 33 + n;
        v4u o; o.x = pk2(s[0 * 33], s[1 * 33]); o.y = pk2(s[2 * 33], s[3 * 33]); o.z = pk2(s[4 * 33], s[5 * 33]); o.w = pk2(s[6 * 33], s[7 * 33]);
        *(v4u*)(WT + (size_t)(row_off + n0 + n) * K + k0 + 8 * c) = o; }
    LDS_WAIT(); asm volatile("" ::: "memory");
}

__device__ __forceinline__ void phase_late_weights(LAS unsigned char* lds, const int wave_s, const int gw, const int NGW) {
    const int lane = (int)__builtin_amdgcn_mbcnt_hi(~0u, __builtin_amdgcn_mbcnt_lo(~0u, 0u));
    LAS float* scr = (LAS float*)(lds + wave_s * 8448);
    constexpr int I1 = 16 * 32, I2 = 16 * 64, IG = 4 * 8, I3 = 16 * 32;
    constexpr int NIT = I1 + I2 + 4 * IG + I3;
    for (int it = gw; it < NIT; it += NGW) {
        int r = it;
        if (r < I1) { transpose_item(KA_IN(10), 1024, 1024, (bf16*)(KA_WS() + WS_W1T), 0, scr, r, lane); continue; } r -= I1;
        if (r < I2) { transpose_item(KA_IN(11), 1024, 2048, (bf16*)(KA_WS() + WS_W2T), 0, scr, r, lane); continue; } r -= I2;
        if (r < 4 * IG) { const int g = r / IG; transpose_item(KA_IN(12) + (size_t)g * 65536, 256, 256, (bf16*)(KA_WS() + WS_WGT), g * 256, scr, r % IG, lane); continue; } r -= 4 * IG;
        transpose_item(KA_IN(14), 1024, 1024, (bf16*)(KA_WS() + WS_W3T), 0, scr, r, lane);
    }
}

__device__ __forceinline__ void phase_prologue(const Args& a, LAS unsigned char* lds, const int wave_s) {
    int tid_ = wave_s * 64 + (int)__builtin_amdgcn_mbcnt_hi(~0u, __builtin_amdgcn_mbcnt_lo(~0u, 0u)); const int tid = tid_, lane = tid & 63, wave = __builtin_amdgcn_readfirstlane(tid >> 6);
    const float* c = KA_IN(1); const float* cctx = KA_IN(3); const float* ada_w = KA_IN(4); const float* ada_b = KA_IN(5);
    float* MOD = (float*)(KA_WS() + WS_MOD);
    LAS float* sil = (LAS float*)(lds + 69632);
    LAS float* red = sil + 9 * 1024;
    bool have_sil = false;
    for (int task = blockIdx.x; task < 192; task += gridDim.x) {
        if (!have_sil) {
            for (int i = tid; i < 9 * 1024; i += 512) { const float v = i < 8192 ? c[i] : cctx[i - 8192]; sil[i] = siluf_(v); }
            have_sil = true;
        }
        __syncthreads();
        const int l = task / 96, n0 = (task % 96) * 32;
        const float* W = ada_w + (size_t)l * 1024 * 3072 + n0 + (lane & 31);
        float acc[9];
#pragma unroll
        for (int r = 0; r < 9; ++r) acc[r] = 0.f;
        const int kb = wave * 128 + (lane >> 5);
#pragma unroll
        for (int i0 = 0; i0 < 64; i0 += 32) { float wv[32];
#pragma unroll
            for (int i = 0; i < 32; ++i) wv[i] = W[(size_t)(kb + 2 * (i0 + i)) * 3072];
#pragma unroll
            for (int i = 0; i < 32; ++i) { const int k = kb + 2 * (i0 + i);
#pragma unroll
                for (int r = 0; r < 9; ++r) acc[r] += sil[r * 1024 + k] * wv[i]; } }
#pragma unroll
        for (int r = 0; r < 9; ++r) acc[r] += __shfl_xor(acc[r], 32);
        if (lane < 32) {
#pragma unroll
            for (int r = 0; r < 9; ++r) red[(wave * 9 + r) * 32 + lane] = acc[r]; }
        __syncthreads();
        if (tid < 288) { const int r = tid >> 5, n = tid & 31; float s = 0.f;
#pragma unroll
            for (int w = 0; w < 8; ++w) s += red[(w * 9 + r) * 32 + n];
            MOD[(size_t)(l * 9 + r) * 3072 + n0 + n] = s + ada_b[l * 3072 + n0 + n]; }
    }
    if (blockIdx.x == gridDim.x - 1) { const float* lg = KA_IN(8); float* LB = (float*)(KA_WS() + WS_LB);
        for (int i = tid; i < 2048; i += 512) LB[i] = sigmoidf_(lg[i]); }
    LAS float* scr = (LAS float*)(lds + wave * 8448);
    const int gw = blockIdx.x * 8 + wave, NGW = gridDim.x * 8;
    constexpr int I0 = 16 * 160;
    for (int it = gw; it < I0; it += NGW) transpose_item(KA_IN(7), 1024, 5120, (bf16*)(KA_WS() + WS_W0T), 0, scr, it, lane);
    if (gridDim.x != 256) phase_late_weights(lds, wave_s, gw, NGW);
}

template <int R> __device__ __forceinline__ void modnorm_rows(const float* xrow0, const float* nw, const float* mod, bf16* orow0, int lane) {
    f32x4 v[R][4]; float rstd[R];
#pragma unroll
    for (int r = 0; r < R; ++r)
#pragma unroll
        for (int j = 0; j < 4; ++j) v[r][j] = ((const f32x4*)(xrow0 + (size_t)r * 1024))[lane + 64 * j];
#pragma unroll
    for (int r = 0; r < R; ++r) { float s = 0.f;
#pragma unroll
        for (int j = 0; j < 4; ++j) s += (v[r][j].x * v[r][j].x + v[r][j].y * v[r][j].y) + (v[r][j].z * v[r][j].z + v[r][j].w * v[r][j].w);
        rstd[r] = __builtin_amdgcn_rsqf(wave_sum(s) * (1.f / 1024.f) + EPS); }
#pragma unroll
    for (int j = 0; j < 4; ++j) { const f32x4 w4 = ((const f32x4*)nw)[lane + 64 * j], sh = ((const f32x4*)mod)[lane + 64 * j], sc = ((const f32x4*)(mod + 1024))[lane + 64 * j];
        const f32x4 g = w4 * (sc + 1.f);
#pragma unroll
        for (int r = 0; r < R; ++r) { const f32x4 y = v[r][j] * rstd[r] * g + sh;
            ((unsigned long long*)(orow0 + (size_t)r * 1024))[lane + 64 * j] = (unsigned long long)pk2(y.x, y.y) | ((unsigned long long)pk2(y.z, y.w) << 32); } }
}
__device__ __forceinline__ void phase_modnorm(const Args& a, int layer, const float* xsrc, int nrows_x, bf16* dst, const int wave_s) {
    int tid_ = wave_s * 64 + (int)__builtin_amdgcn_mbcnt_hi(~0u, __builtin_amdgcn_mbcnt_lo(~0u, 0u)); const int lane = tid_ & 63, wave = tid_ >> 6;
    const int gw = blockIdx.x * 8 + wave, NGW = gridDim.x * 8;
    const float* MOD = (const float*)(KA_WS() + WS_MOD) + (size_t)layer * 9 * 3072;
    const float* nw = KA_IN(6) + layer * 1024;
    for (int m = gw * 4; m < MT; m += NGW * 4) modnorm_rows<4>(xsrc + (size_t)m * 1024, nw, MOD + (size_t)(m >> 11) * 3072, dst + (size_t)m * 1024, lane);
    if (layer == 0) { const float* cx = KA_IN(2);
        for (int m = gw; m < MC; m += NGW) modnorm_rows<1>(cx + (size_t)m * 1024, nw, MOD + (size_t)8 * 3072, dst + (size_t)(MT + m) * 1024, lane); }
}
__device__ __forceinline__ void phase_headnorm(const Args& a, const int wave_s) {
    int tid_ = wave_s * 64 + (int)__builtin_amdgcn_mbcnt_hi(~0u, __builtin_amdgcn_mbcnt_lo(~0u, 0u)); const int lane = tid_ & 63, wave = tid_ >> 6;
    const int gw = blockIdx.x * 8 + wave, NGW = gridDim.x * 8;
    const bf16* OF = (const bf16*)KA_OUT(); const bf16* OB = (const bf16*)(KA_WS() + WS_OB); const bf16* Z = (const bf16*)(KA_WS() + WS_Z); bf16* A1 = (bf16*)(KA_WS() + WS_A1);
    const float* gwt = KA_IN(9);
    constexpr int R = 4;
    for (int m = gw * R; m < MT; m += NGW * R) {
        v4u of[R][2], ob[R][2], zz[R][2];
#pragma unroll
        for (int r = 0; r < R; ++r)
#pragma unroll
            for (int j = 0; j < 2; ++j) { const size_t o = (size_t)(m + r) * 1024 + 512 * j + 8 * lane;
                of[r][j] = *(const v4u*)(OF + o); ob[r][j] = *(const v4u*)(OB + o); zz[r][j] = *(const v4u*)(Z + o); }
#pragma unroll
        for (int j = 0; j < 2; ++j) { const f32x4 w0 = *(const f32x4*)(gwt + 512 * j + 8 * lane), w1 = *(const f32x4*)(gwt + 512 * j + 8 * lane + 4);
#pragma unroll
            for (int r = 0; r < R; ++r) { float o[8]; float s = 0.f;
#pragma unroll
                for (int e = 0; e < 4; ++e) { o[2 * e] = bflo(of[r][j][e]) + bflo(ob[r][j][e]); o[2 * e + 1] = bfhi(of[r][j][e]) + bfhi(ob[r][j][e]); s += o[2 * e] * o[2 * e] + o[2 * e + 1] * o[2 * e + 1]; }
#pragma unroll
                for (int sh = 1; sh < 16; sh <<= 1) s += __shfl_xor(s, sh);
                const float rstd = __builtin_amdgcn_rsqf(s * (1.f / 128.f) + EPS);
                v4u out;
#pragma unroll
                for (int e = 0; e < 4; ++e) { const float wa = e < 2 ? w0[2 * e] : w1[2 * e - 4], wb = e < 2 ? w0[2 * e + 1] : w1[2 * e - 3];
                    out[e] = pk2(o[2 * e] * rstd * wa * bflo(zz[r][j][e]), o[2 * e + 1] * rstd * wb * bfhi(zz[r][j][e])); }
                *(v4u*)(A1 + (size_t)(m + r) * 1024 + 512 * j + 8 * lane) = out; } }
    }
}
__device__ __forceinline__ void phase_pool(const Args& a, LAS unsigned char* lds, const int wave_s) {
    int tid_ = wave_s * 64 + (int)__builtin_amdgcn_mbcnt_hi(~0u, __builtin_amdgcn_mbcnt_lo(~0u, 0u)); const int tid = tid_;
    const bf16* Ub = (const bf16*)(KA_WS() + WS_U); bf16* A3 = (bf16*)(KA_WS() + WS_A3);
    v4u pre[4];
    int unit = blockIdx.x, buf = 0;
#define POOL_LOAD(un) do { const bf16* U_ = Ub + (size_t)((un) >> 2) * 64 * 1024 + ((un) & 3) * 256; \
        _Pragma("unroll") for (int i = 0; i < 4; ++i) { const int idx = tid + 512 * i; pre[i] = *(const v4u*)(U_ + (size_t)(idx >> 5) * 1024 + 8 * (idx & 31)); } } while (0)
    if (unit < 1024) POOL_LOAD(unit);
    for (; unit < 1024; unit += gridDim.x, buf ^= 1) {
        LAS float* T = (LAS float*)(lds + buf * 65536);
#pragma unroll
        for (int i = 0; i < 4; ++i) { const int idx = tid + 512 * i; LAS float* tp = T + (idx >> 5) * 256 + 8 * (idx & 31);
            *(LAS f32x4*)tp = (f32x4){bflo(pre[i][0]), bfhi(pre[i][0]), bflo(pre[i][1]), bfhi(pre[i][1])};
            *(LAS f32x4*)(tp + 4) = (f32x4){bflo(pre[i][2]), bfhi(pre[i][2]), bflo(pre[i][3]), bfhi(pre[i][3])}; }
        __syncthreads();
        if (unit + (int)gridDim.x < 1024) POOL_LOAD(unit + gridDim.x);
        const int g = unit & 3, br = unit >> 2;
        const int c = 2 * (tid & 127), t0 = (tid >> 7) * 16, hw = 1 << g;
        int lo = max(t0 - hw, 0), hi = min(t0 + hw, 64); f32x2 s = (f32x2){0.f, 0.f};
        for (int j = lo; j < hi; ++j) s += *(const LAS f32x2*)(T + j * 256 + c);
        bf16* op = A3 + (size_t)(br * 64) * 1024 + g * 256 + c;
#pragma unroll 4
        for (int t = t0; t < t0 + 16; ++t) {
            if (t > t0) { const int nlo = max(t - hw, 0), nhi = min(t + hw, 64);
                if (nhi > hi) s += *(const LAS f32x2*)(T + (nhi - 1) * 256 + c);
                if (nlo > lo) s -= *(const LAS f32x2*)(T + lo * 256 + c);
                lo = nlo; hi = nhi; }
            const float inv = fast_rcp((float)(hi - lo)); const f32x2 ctr = *(const LAS f32x2*)(T + t * 256 + c);
            *(unsigned*)(op + (size_t)t * 1024) = pk2(s.x * inv - ctr.x, s.y * inv - ctr.y);
        }
    }
    __syncthreads();
#undef POOL_LOAD
}
__device__ __forceinline__ void phase_final(const Args& a, const int wave_s) {
    int tid_ = wave_s * 64 + (int)__builtin_amdgcn_mbcnt_hi(~0u, __builtin_amdgcn_mbcnt_lo(~0u, 0u)); const int lane = tid_ & 63, wave = tid_ >> 6;
    const int gw = blockIdx.x * 8 + wave, NGW = gridDim.x * 8;
    const float* fw = KA_IN(15); float* out = KA_OUT();
    constexpr int R = 4;
    for (int m = gw * R; m < MT; m += NGW * R) {
        f32x4 v[R][4]; float rstd[R];
#pragma unroll
        for (int r = 0; r < R; ++r)
#pragma unroll
            for (int j = 0; j < 4; ++j) v[r][j] = ((const f32x4*)(out + (size_t)(m + r) * 1024))[lane + 64 * j];
#pragma unroll
        for (int r = 0; r < R; ++r) { float s = 0.f;
#pragma unroll
            for (int j = 0; j < 4; ++j) s += (v[r][j].x * v[r][j].x + v[r][j].y * v[r][j].y) + (v[r][j].z * v[r][j].z + v[r][j].w * v[r][j].w);
            rstd[r] = __builtin_amdgcn_rsqf(wave_sum(s) * (1.f / 1024.f) + EPS); }
#pragma unroll
        for (int j = 0; j < 4; ++j) { const f32x4 w4 = ((const f32x4*)fw)[lane + 64 * j];
#pragma unroll
            for (int r = 0; r < R; ++r) ((f32x4*)(out + (size_t)(m + r) * 1024))[lane + 64 * j] = v[r][j] * rstd[r] * w4; }
    }
}
constexpr int QS_OFF = 0, KS_OFF = 17408, KST_OFF = 34816, VT_OFF = 53248, SPT_OFF = 62464, TOT_OFF = 79872;
__device__ __forceinline__ f32x4 mfma16(bf16x8 a, bf16x8 b, f32x4 c) { return __builtin_amdgcn_mfma_f32_16x16x32_bf16(a, b, c, 0, 0, 0); }
__device__ __forceinline__ bf16x8 as_bf16x8(v4u v) { return __builtin_bit_cast(bf16x8, v); }

struct GlaRegs { unsigned f[8], q[8], v[8]; };
struct GlaCtx { const bf16* Fq; const bf16* Qb; const bf16* Vb; bf16* O; int b, h, dir, vs, w, lane, fr, fq; };
__device__ __forceinline__ int gla_rowbase(const GlaCtx& c, int i) { return i < 4 ? (MT + c.b * 256 + (c.dir ? 3 - i : i) * 64) : (c.b * 2048 + (c.dir ? 35 - i : i - 4) * 64); }
template <bool WITH_Q> __device__ __forceinline__ void gla_load(GlaRegs& R, const GlaCtx& c, int i) {
    const int rb = gla_rowbase(c, i);
#pragma unroll
    for (int jj = 0; jj < 8; ++jj) { const int r = 8 * c.w + jj; const size_t g = (size_t)(rb + (c.dir ? 63 - r : r)) * 1024 + c.h * 128;
        R.f[jj] = *(const unsigned*)(c.Fq + g + 2 * c.lane);
        if (WITH_Q) R.q[jj] = *(const unsigned*)(c.Qb + g + 2 * c.lane);
        R.v[jj] = *(const unsigned*)(c.Vb + g + c.vs * 64 + 2 * (c.lane & 31)); }
}
template <bool OUT, bool NEXT_Q> __device__ __forceinline__ void gla_step(GlaRegs& R, const GlaCtx& c, const int i, const int inext, f32x4 (&S)[4], LAS unsigned char* lds) {
    LAS unsigned char* QS = lds + QS_OFF; LAS unsigned char* KS = lds + KS_OFF; LAS unsigned char* KST = lds + KST_OFF;
    LAS unsigned char* VT = lds + VT_OFF; LAS unsigned char* SPT = lds + SPT_OFF; LAS float* TOT = (LAS float*)(lds + TOT_OFF);
    const int w = c.w, lane = c.lane, fr = c.fr, fq = c.fq, ci = w & 3, vh = w >> 2;
    constexpr bool has_out = OUT;
    float f0[8], f1[8], p0[8], p1[8]; float run0 = 1.f, run1 = 1.f;
#pragma unroll
    for (int jj = 0; jj < 8; ++jj) { f0[jj] = (float)(R.f[jj] & 0xffffu) * (1.f / 65535.f); f1[jj] = (float)(R.f[jj] >> 16) * (1.f / 65535.f);
        run0 *= f0[jj]; run1 *= f1[jj]; p0[jj] = run0; p1[jj] = run1; }
    *(LAS f32x2*)(TOT + w * 128 + 2 * lane) = (f32x2){run0, run1};
    __syncthreads();
    float pre0 = 1.f, pre1 = 1.f, mid0 = 1.f, mid1 = 1.f;
#pragma unroll
    for (int j = 0; j < 8; ++j) { const f32x2 t = *(const LAS f32x2*)(TOT + j * 128 + 2 * lane);
        pre0 *= (j < w) ? t.x : 1.f; pre1 *= (j < w) ? t.y : 1.f; if (j < 4) { mid0 *= t.x; mid1 *= t.y; } }
    const float rmid0 = fast_rcp(mid0), rmid1 = fast_rcp(mid1);
    unsigned kt0[4], kt1[4];
#pragma unroll
    for (int jj = 0; jj < 8; jj += 2) {
        float ka[2], kb[2];
#pragma unroll
        for (int e = 0; e < 2; ++e) { const int j2 = jj + e;
            const float pc0 = p0[j2] * pre0, pc1 = p1[j2] * pre1;
            const float ks0 = (1.f - f0[j2]) * mid0 * fast_rcp(pc0), ks1 = (1.f - f1[j2]) * mid1 * fast_rcp(pc1);
            ka[e] = ks0; kb[e] = ks1;
            if (has_out) {
                *(LAS unsigned*)(KS + (8 * w + j2) * 272 + 4 * lane) = pk2(ks0, ks1);
                const float qs0 = bflo(R.q[j2]) * pc0 * rmid0, qs1 = bfhi(R.q[j2]) * pc1 * rmid1;
                *(LAS unsigned*)(QS + (8 * w + j2) * 272 + 4 * lane) = pk2(qs0, qs1); } }
        kt0[jj >> 1] = pk2(ka[0], ka[1]); kt1[jj >> 1] = pk2(kb[0], kb[1]); }
    *(LAS v4u*)(KST + (2 * lane) * 144 + 16 * w) = (v4u){kt0[0], kt0[1], kt0[2], kt0[3]};
    *(LAS v4u*)(KST + (2 * lane + 1) * 144 + 16 * w) = (v4u){kt1[0], kt1[1], kt1[2], kt1[3]};
    if (lane < 32) {
        *(LAS v4u*)(VT + (2 * lane) * 144 + 16 * w) = (v4u){__builtin_amdgcn_perm(R.v[1], R.v[0], 0x05040100u), __builtin_amdgcn_perm(R.v[3], R.v[2], 0x05040100u), __builtin_amdgcn_perm(R.v[5], R.v[4], 0x05040100u), __builtin_amdgcn_perm(R.v[7], R.v[6], 0x05040100u)};
        *(LAS v4u*)(VT + (2 * lane + 1) * 144 + 16 * w) = (v4u){__builtin_amdgcn_perm(R.v[1], R.v[0], 0x07060302u), __builtin_amdgcn_perm(R.v[3], R.v[2], 0x07060302u), __builtin_amdgcn_perm(R.v[5], R.v[4], 0x07060302u), __builtin_amdgcn_perm(R.v[7], R.v[6], 0x07060302u)}; }
    f32x4 pm4 = (f32x4){1.f, 1.f, 1.f, 1.f}, pl4 = pm4;
#pragma unroll
    for (int j = 0; j < 8; ++j) { const f32x4 t = *(const LAS f32x4*)(TOT + j * 128 + 16 * w + 4 * fq); pl4 *= t; if (j < 4) pm4 *= t; }
    if (has_out) {
#pragma unroll
        for (int vb = 0; vb < 4; ++vb) { const f32x4 sp = pm4 * S[vb];
            *(LAS v2u*)(SPT + (16 * vb + fr) * 272 + (16 * w + 4 * fq) * 2) = (v2u){pk2(sp[0], sp[1]), pk2(sp[2], sp[3])}; } }
    gla_load<NEXT_Q>(R, c, inext);
    __syncthreads();
    __builtin_amdgcn_s_setprio(1);
    if (has_out) {
        bf16x8 qf[4];
#pragma unroll
        for (int kk = 0; kk < 4; ++kk) qf[kk] = *(const LAS bf16x8*)(QS + (16 * ci + fr) * 272 + (32 * kk + 8 * fq) * 2);
        f32x4 at[4];
#pragma unroll
        for (int sb = 0; sb < 4; ++sb) { at[sb] = (f32x4){0.f, 0.f, 0.f, 0.f};
            if (sb <= ci) {
#pragma unroll
                for (int kk = 0; kk < 4; ++kk) { const bf16x8 kf = *(const LAS bf16x8*)(KS + (16 * sb + fr) * 272 + (32 * kk + 8 * fq) * 2); at[sb] = mfma16(kf, qf[kk], at[sb]); }
                if (sb == ci) {
#pragma unroll
                    for (int jj = 0; jj < 4; ++jj) at[sb][jj] = (4 * fq + jj <= fr) ? at[sb][jj] : 0.f; } } }
        f32x4 oacc[2]; oacc[0] = (f32x4){0.f, 0.f, 0.f, 0.f}; oacc[1] = oacc[0];
#pragma unroll
        for (int k2 = 0; k2 < 2; ++k2) {
            if (2 * k2 <= ci) {
                const bf16x8 pb = as_bf16x8((v4u){pk2(at[2 * k2][0], at[2 * k2][1]), pk2(at[2 * k2][2], at[2 * k2][3]), pk2(at[2 * k2 + 1][0], at[2 * k2 + 1][1]), pk2(at[2 * k2 + 1][2], at[2 * k2 + 1][3])});
#pragma unroll
                for (int vt = 0; vt < 2; ++vt) { const LAS unsigned char* vp = VT + (16 * (2 * vh + vt) + fr) * 144 + (32 * k2 + 4 * fq) * 2;
                    const v2u lo = *(const LAS v2u*)vp, hi = *(const LAS v2u*)(vp + 32);
                    oacc[vt] = mfma16(as_bf16x8((v4u){lo[0], lo[1], hi[0], hi[1]}), pb, oacc[vt]); } } }
#pragma unroll
        for (int kk = 0; kk < 4; ++kk)
#pragma unroll
            for (int vt = 0; vt < 2; ++vt) { const bf16x8 sf = *(const LAS bf16x8*)(SPT + (16 * (2 * vh + vt) + fr) * 272 + (32 * kk + 8 * fq) * 2); oacc[vt] = mfma16(sf, qf[kk], oacc[vt]); }
        const int r = 16 * ci + fr; const size_t go = (size_t)(gla_rowbase(c, i) + (c.dir ? 63 - r : r)) * 1024 + c.h * 128 + c.vs * 64 + 4 * fq;
#pragma unroll
        for (int vt = 0; vt < 2; ++vt) *(v2u*)(c.O + go + 16 * (2 * vh + vt)) = (v2u){pk2(oacc[vt][0], oacc[vt][1]), pk2(oacc[vt][2], oacc[vt][3])};
    }
    {
        bf16x8 ka[2];
#pragma unroll
        for (int ss = 0; ss < 2; ++ss) ka[ss] = *(const LAS bf16x8*)(KST + (16 * w + fr) * 144 + (32 * ss + 8 * fq) * 2);
        f32x4 sc;
#pragma unroll
        for (int e = 0; e < 4; ++e) sc[e] = pl4[e] * fast_rcp(pm4[e]);
#pragma unroll
        for (int vb = 0; vb < 4; ++vb) { f32x4 uu = (f32x4){0.f, 0.f, 0.f, 0.f};
#pragma unroll
            for (int ss = 0; ss < 2; ++ss) { const bf16x8 vf = *(const LAS bf16x8*)(VT + (16 * vb + fr) * 144 + (32 * ss + 8 * fq) * 2); uu = mfma16(ka[ss], vf, uu); }
            S[vb] = pl4 * S[vb] + sc * uu; }
    }
    __builtin_amdgcn_s_setprio(0);
}
__device__ __forceinline__ void phase_gla(const Args& a, LAS unsigned char* lds, const int wave_s) {
    int tid_ = wave_s * 64 + (int)__builtin_amdgcn_mbcnt_hi(~0u, __builtin_amdgcn_mbcnt_lo(~0u, 0u)); const int tid = tid_, lane = tid & 63, w = __builtin_amdgcn_readfirstlane(tid >> 6);
    unsigned char* ws = KA_WS();
    for (int u = blockIdx.x; u < 256; u += gridDim.x) {
        const int vs = (u >> 3) & 1, dir = (u >> 4) & 1, rest = (u & 7) | ((u >> 5) << 3), h = rest & 7, b = rest >> 3;
        GlaCtx c; c.Fq = (const bf16*)(ws + (dir ? WS_FB : WS_FF)); c.Qb = (const bf16*)(ws + WS_Q); c.Vb = (const bf16*)(ws + WS_V);
        c.O = dir ? (bf16*)(ws + WS_OB) : (bf16*)KA_OUT(); c.b = b; c.h = h; c.dir = dir; c.vs = vs; c.w = w; c.lane = lane; c.fr = lane & 15; c.fq = lane >> 4;
        f32x4 S[4];
#pragma unroll
        for (int i = 0; i < 4; ++i) S[i] = (f32x4){0.f, 0.f, 0.f, 0.f};
        GlaRegs RA, RB;
        gla_load<false>(RA, c, 0); gla_load<false>(RB, c, 1);
        gla_step<false, false>(RA, c, 0, 2, S, lds); gla_step<false, false>(RB, c, 1, 3, S, lds);
        gla_step<false, true>(RA, c, 2, 4, S, lds); gla_step<false, true>(RB, c, 3, 5, S, lds);
        for (int i = 4; i < 36; i += 2) { gla_step<true, true>(RA, c, i, min(i + 2, 35), S, lds); gla_step<true, true>(RB, c, i + 1, min(i + 3, 35), S, lds); }
        __syncthreads();
    }
}

__device__ __forceinline__ void phase_pool_grp(LAS unsigned char* lds, const int wave_s) {
    int tid_ = wave_s * 64 + (int)__builtin_amdgcn_mbcnt_hi(~0u, __builtin_amdgcn_mbcnt_lo(~0u, 0u)); const int tid = tid_, lane = tid & 63, w = wave_s, fr = lane & 15, fq = lane >> 4;
    unsigned char* ws = KA_WS();
    const bf16* Ub = (const bf16*)(ws + WS_U); const bf16* ZP = (const bf16*)(ws + WS_ZP); const bf16* WG = (const bf16*)(ws + WS_WGT); bf16* A4 = (bf16*)(ws + WS_A4);
    const float* scale = KA_IN(13);
    LAS unsigned char* P = lds + 65536;
    v4u pre[4]; bf16x8 bfr[2][8]; int gcur = -1;
    int unit = blockIdx.x, buf = 0;
#define POOL_LOAD(un) do { const bf16* U_ = Ub + (size_t)((un) >> 2) * 64 * 1024 + ((un) & 3) * 256; \
        _Pragma("unroll") for (int i = 0; i < 4; ++i) { const int idx = tid + 512 * i; pre[i] = *(const v4u*)(U_ + (size_t)(idx >> 5) * 1024 + 8 * (idx & 31)); } } while (0)
    if (unit < 1024) POOL_LOAD(unit);
    for (; unit < 1024; unit += gridDim.x, buf ^= 1) {
        LAS unsigned char* T = lds + buf * 32768;
#pragma unroll
        for (int i = 0; i < 4; ++i) { const int idx = tid + 512 * i; *(LAS v4u*)(T + (idx >> 5) * 512 + 16 * (idx & 31)) = pre[i]; }
        __syncthreads();
        if (unit + (int)gridDim.x < 1024) POOL_LOAD(unit + gridDim.x);
        const int g = unit & 3, br = unit >> 2;
        if (g != gcur) { gcur = g;
#pragma unroll
            for (int nt = 0; nt < 2; ++nt)
#pragma unroll
                for (int kk = 0; kk < 8; ++kk) { const int ncol = 32 * w + 8 * (fr >> 2) + 4 * nt + (fr & 3);
                    bfr[nt][kk] = *(const bf16x8*)(WG + (size_t)(g * 256 + ncol) * 256 + 32 * kk + 8 * fq); } }
        const int colb = g * 256 + 32 * w + 8 * fq;
        v4u zz[4];
#pragma unroll
        for (int mt = 0; mt < 4; ++mt) zz[mt] = *(const v4u*)(ZP + (size_t)(br * 64 + 16 * mt + fr) * 1024 + colb);
        {
            const int cp = tid & 127, t0 = (tid >> 7) * 16, hw = 1 << g;
            int lo = max(t0 - hw, 0), hi = min(t0 + hw, 64); f32x2 s = (f32x2){0.f, 0.f};
            for (int j = lo; j < hi; ++j) { const unsigned d = *(const LAS unsigned*)(T + j * 512 + 4 * cp); s.x += bflo(d); s.y += bfhi(d); }
#pragma unroll 4
            for (int t = t0; t < t0 + 16; ++t) {
                if (t > t0) { const int nlo = max(t - hw, 0), nhi = min(t + hw, 64);
                    if (nhi > hi) { const unsigned d = *(const LAS unsigned*)(T + (nhi - 1) * 512 + 4 * cp); s.x += bflo(d); s.y += bfhi(d); }
                    if (nlo > lo) { const unsigned d = *(const LAS unsigned*)(T + lo * 512 + 4 * cp); s.x -= bflo(d); s.y -= bfhi(d); }
                    lo = nlo; hi = nhi; }
                const float inv = fast_rcp((float)(hi - lo)); const unsigned ctr = *(const LAS unsigned*)(T + t * 512 + 4 * cp);
                *(LAS unsigned*)(P + t * 528 + 4 * cp) = pk2(s.x * inv - bflo(ctr), s.y * inv - bfhi(ctr));
            }
        }
        __syncthreads();
        f32x4 acc[4][2];
#pragma unroll
        for (int mt = 0; mt < 4; ++mt) { acc[mt][0] = (f32x4){0.f, 0.f, 0.f, 0.f}; acc[mt][1] = acc[mt][0]; }
#pragma unroll
        for (int kk = 0; kk < 8; ++kk)
#pragma unroll
            for (int mt = 0; mt < 4; ++mt) { const bf16x8 afr = *(const LAS bf16x8*)(P + (16 * mt + fr) * 528 + (32 * kk + 8 * fq) * 2);
                acc[mt][0] = mfma16(bfr[0][kk], afr, acc[mt][0]); acc[mt][1] = mfma16(bfr[1][kk], afr, acc[mt][1]); }
        const f32x4 sc0 = *(const f32x4*)(scale + colb), sc1 = *(const f32x4*)(scale + colb + 4);
#pragma unroll
        for (int mt = 0; mt < 4; ++mt) { const size_t o = (size_t)(br * 64 + 16 * mt + fr) * 1024 + colb;
            const f32x4 v0 = acc[mt][0] * sc0, v1 = acc[mt][1] * sc1;
            *(v4u*)(A4 + o) = (v4u){pk2(v0[0] * bflo(zz[mt][0]), v0[1] * bfhi(zz[mt][0])), pk2(v0[2] * bflo(zz[mt][1]), v0[3] * bfhi(zz[mt][1])),
                                     pk2(v1[0] * bflo(zz[mt][2]), v1[1] * bfhi(zz[mt][2])), pk2(v1[2] * bflo(zz[mt][3]), v1[3] * bfhi(zz[mt][3]))}; }
    }
    __syncthreads();
#undef POOL_LOAD
}

struct InProjOrder {
    pg8::StaticOrder lat;
    __device__ __forceinline__ bool next(int i, pg8::Unit& u) const {
        if (lat.next(i, u)) return true;
        const long t = (long)i * lat.G + lat.c - lat.nwg;
        if (t >= 96) return false;
        u.pm = 64 + (int)(t / 12); u.pn = (int)(t % 12); return true;
    }
    __device__ __forceinline__ void a_ready(const pg8::Unit&) const {}
    __device__ __forceinline__ void done(const pg8::Unit&) const {}
};

__global__ void __launch_bounds__(512, 2) mega_fwd(Args a) {
    extern __shared__ __attribute__((aligned(16))) unsigned char lds_raw[];
    LAS unsigned char* lds = (LAS unsigned char*)lds_raw;
    const int lo = karg_i32(144), hi = karg_i32(148);
    const int wave_s = __builtin_amdgcn_readfirstlane(threadIdx.x >> 6);
#ifndef PROBE_MASK
#define PROBE_MASK 0
#endif
#define IN(k) (lo <= (k) && (k) < hi)
#define REP(k) for (int rep_ = 0; rep_ < (((PROBE_MASK) >> (k)) & 1) + 1; ++rep_, ((((PROBE_MASK) >> (k)) & 1) && rep_ == 1 ? xcd_barrier((unsigned*)(KA_WS() + WS_BAR), (volatile LAS unsigned*)(lds + LDS_ST_OFF), (wave_s == 0) && (__builtin_amdgcn_mbcnt_hi(~0u, __builtin_amdgcn_mbcnt_lo(~0u, 0u)) == 0u)) : (void)0))
#ifndef SYNC_REPS
#define SYNC_REPS 1
#endif
    volatile LAS unsigned* bar_st = (volatile LAS unsigned*)(lds + LDS_ST_OFF);
    const bool leader = (wave_s == 0) && (__builtin_amdgcn_mbcnt_hi(~0u, __builtin_amdgcn_mbcnt_lo(~0u, 0u)) == 0u);
    if (leader) { bar_st[0] = 0u; bar_st[1] = 0u; (void)xb_add((unsigned*)(KA_WS() + WS_BAR) + XB_XCNT(xb_xcc_id()), 1u); }
    __syncthreads();
    if (lo < -1000) cg::this_grid().sync();
#define SEAM(k) do { if (IN(k) && IN((k) + 1)) for (int sr_ = 0; sr_ < SYNC_REPS; ++sr_) xcd_barrier((unsigned*)(KA_WS() + WS_BAR), bar_st, leader); } while (0)
    unsigned char* ws = KA_WS();
    if (IN(0)) REP(0) { phase_prologue(a, lds, wave_s); } SEAM(0);
    if (IN(1)) REP(1) { phase_modnorm(a, 0, KA_IN(0), MT, (bf16*)KA_OUT(), wave_s); } SEAM(1);
    if (IN(2)) REP(2) {
        EpiInProj E{ws, 0};
        pg8::Gemm g{(const bf16*)KA_OUT(), (const bf16*)(ws + WS_W0T), MT, 5120, 1024, 1024, 1024, 0}; InProjOrder S; S.lat.init(MT, 5120, gridDim.x, blockIdx.x);
        pg8::gemm_phase<EpiInProj, InProjOrder>(lds, g, S, E, wave_s);
        if (gridDim.x == 256 && blockIdx.x >= 96) phase_late_weights(lds, wave_s, ((int)blockIdx.x - 96) * 8 + wave_s, 160 * 8);
    } SEAM(2);
    if (IN(3)) REP(3) { phase_gla(a, lds, wave_s); } SEAM(3);
    if (IN(4)) REP(4) { phase_headnorm(a, wave_s); } SEAM(4);
    const bool fuse = (gridDim.x == 256);
    if (IN(5)) REP(5) {
        pg8::Gemm g{(const bf16*)(ws + WS_A1), (const bf16*)(ws + WS_W1T), MT, 1024, 1024, 1024, 1024, 0}; pg8::StaticOrder S; S.init(MT, 1024, gridDim.x, blockIdx.x);
        if (fuse) {
            EpiResidNorm<0> E{KA_IN(0), (void*)(ws + WS_X1), (const float*)(ws + WS_MOD) + 2048, KA_IN(6) + 1024, (const float*)(ws + WS_MOD) + 9 * 3072, (bf16*)(ws + WS_A2),
                              (float*)(ws + WS_PART), (unsigned*)(ws + WS_BAR) + BAR_CNT_WORD0, (unsigned*)(ws + WS_BAR)};
            pg8::gemm_phase<EpiResidNorm<0>, pg8::StaticOrder>(lds, g, S, E, wave_s);
        } else {
            EpiResid E{KA_IN(0), (float*)(ws + WS_X1), (const float*)(ws + WS_MOD) + 2048};
            pg8::gemm_phase<EpiResid, pg8::StaticOrder>(lds, g, S, E, wave_s);
        }
    } SEAM(5);
    if (IN(6) && !fuse) REP(6) { phase_modnorm(a, 1, (const float*)(ws + WS_X1), MT, (bf16*)(ws + WS_A2), wave_s); }
    if (!fuse) SEAM(6);
    if (IN(7)) REP(7) {
        EpiPoolIn E{(bf16*)(ws + WS_U), (bf16*)(ws + WS_ZP)};
        pg8::Gemm g{(const bf16*)(ws + WS_A2), (const bf16*)(ws + WS_W2T), MT, 2048, 1024, 1024, 1024, 0}; pg8::StaticOrder S; S.init(MT, 2048, gridDim.x, blockIdx.x);
        pg8::gemm_phase<EpiPoolIn, pg8::StaticOrder>(lds, g, S, E, wave_s);
    } SEAM(7);
    if (IN(8)) REP(8) { phase_pool_grp(lds, wave_s); } SEAM(8);
    if (IN(10)) REP(10) {
        pg8::Gemm g{(const bf16*)(ws + WS_A4), (const bf16*)(ws + WS_W3T), MT, 1024, 1024, 1024, 1024, 0}; pg8::StaticOrder S; S.init(MT, 1024, gridDim.x, blockIdx.x);
        if (fuse) {
            EpiResidNorm<1> E{(const void*)(ws + WS_X1), (void*)KA_OUT(), (const float*)(ws + WS_MOD) + 9 * 3072 + 2048, KA_IN(15), nullptr, nullptr,
                              (float*)(ws + WS_PART) + (size_t)MT * 16, (unsigned*)(ws + WS_BAR) + BAR_CNT_WORD0 + 4096, (unsigned*)(ws + WS_BAR)};
            pg8::gemm_phase<EpiResidNorm<1>, pg8::StaticOrder>(lds, g, S, E, wave_s);
        } else {
            EpiResid E{(const float*)(ws + WS_X1), KA_OUT(), (const float*)(ws + WS_MOD) + 9 * 3072 + 2048};
            pg8::gemm_phase<EpiResid, pg8::StaticOrder>(lds, g, S, E, wave_s);
        }
    }
    if (!fuse) { SEAM(10); if (IN(11)) REP(11) { phase_final(a, wave_s); } }
#undef IN
#undef SEAM
}

extern "C" void kernel_launch(void* const* d_in, const int* in_sizes, int n_in, void* d_out, int out_size, void* d_ws, size_t ws_size, hipStream_t stream) {
    static int grid = 0;
    if (grid == 0) {
        if (n_in != 16 || out_size != MT * D || ws_size < WS_END) { fprintf(stderr, "kernel_launch: unexpected shapes (n_in %d out %d ws %zu)\n", n_in, out_size, ws_size); grid = -1; return; }
        int dev = 0, cus = 0, per_cu = 0;
        (void)hipGetDevice(&dev); (void)hipDeviceGetAttribute(&cus, hipDeviceAttributeMultiprocessorCount, dev);
        if (hipFuncSetAttribute((const void*)mega_fwd, hipFuncAttributeMaxDynamicSharedMemorySize, LDS_BYTES) != hipSuccess) fprintf(stderr, "kernel_launch: hipFuncSetAttribute failed\n");
        if (hipOccupancyMaxActiveBlocksPerMultiprocessor(&per_cu, (const void*)mega_fwd, 512, LDS_BYTES) != hipSuccess || per_cu < 1) { fprintf(stderr, "kernel_launch: occupancy query gave %d\n", per_cu); per_cu = 1; }
        (void)hipGetLastError();
        grid = cus * per_cu;
        fprintf(stderr, "kernel_launch: grid %d (cus %d x %d)\n", grid, cus, per_cu);
    }
    if (grid < 0) return;
    Args a{};
    for (int i = 0; i < 16; ++i) a.in[i] = (const float*)d_in[i];
    a.out = (float*)d_out; a.ws = (unsigned char*)d_ws;
#if MK_N_LAUNCHES == 1
    if (hipMemsetAsync((char*)d_ws + WS_BAR, 0, BAR_BYTES, stream) != hipSuccess) fprintf(stderr, "kernel_launch: memset of barrier words failed\n");
    a.ph_lo = 0; a.ph_hi = NPHASE;
    void* args[] = {&a};
    hipError_t e = hipLaunchCooperativeKernel((const void*)mega_fwd, dim3(grid), dim3(512), args, LDS_BYTES, stream);
    if (e != hipSuccess) fprintf(stderr, "kernel_launch: cooperative launch failed: %s (grid %d)\n", hipGetErrorString(e), grid);
#else
    for (int ph = 0; ph < NPHASE; ++ph) { a.ph_lo = ph; a.ph_hi = ph + 1; hipLaunchKernelGGL(mega_fwd, dim3(grid), dim3(512), LDS_BYTES, stream, a); }
#endif
}
```

```cpp
#include <hip/hip_runtime.h>
#include <hip/hip_cooperative_groups.h>
#include <cstdio>
#include <cstdint>
namespace cg = cooperative_groups;
#ifndef MK_N_LAUNCHES
#define MK_N_LAUNCHES 1
#define PROBE_MASK 0
#endif
namespace pg8 {
#define PG8_LAS __attribute__((address_space(3)))
typedef unsigned short bf16_t;
typedef short bf16x8 __attribute__((ext_vector_type(8)));
typedef float f32x4 __attribute__((ext_vector_type(4)));
typedef unsigned u32x4 __attribute__((ext_vector_type(4)));
constexpr int BM = 256, BK = 64, HALF = 128, HTB = HALF * BK * 2  , STAGE_BYTES = 8 * HTB, NXCD = 8, WGM = 8;

__host__ __device__ __forceinline__ int lds_byte(int r, int c) { const int st = (r >> 4) * 2 + (c >> 5), rr = r & 15, cc = c & 31, ob = rr * 64 + cc * 2; return st * 1024 + (ob ^ (((ob >> 9) & 1) << 5)); }
__host__ __device__ __forceinline__ void stage_rc(int b, int& R, int& C) { const int st = b / 1024, sb = b % 1024, swz = sb ^ (((sb >> 9) & 1) << 5); R = (st >> 1) * 16 + swz / 64; C = (st & 1) * 32 + (swz % 64) / 2; }
__host__ __device__ __forceinline__ int perm32(int rho) { const int n = rho >> 4, i = rho & 15; return 8 * (i >> 2) + 4 * n + (i & 3); }

struct Unit { int pm, pn; };
struct Gemm { const bf16_t* A; const bf16_t* Bt; int M, N, K, lda, ldb, a_pn_bytes; };

struct StaticOrder {
    int nM, nN, nwg, G, c;
    __host__ __device__ void init(int M, int N, int G_, int c_) { nM = M / BM; nN = N / BM; nwg = nM * nN; G = G_; c = c_; }
    __host__ __device__ bool next(int i, Unit& u) const {
        const long L = (long)i * G + c; if (L >= nwg) return false;
        int wgid = (int)L; { const int q = nwg / NXCD, r = nwg % NXCD, xcd = wgid % NXCD, off = wgid / NXCD; wgid = (xcd < r ? xcd * (q + 1) : r * (q + 1) + (xcd - r) * q) + off; }
        const int nig = WGM * nN, gid = wgid / nig, fm = gid * WGM, gsz = (nM - fm) < WGM ? (nM - fm) : WGM;
        u.pm = fm + ((wgid % nig) % gsz); u.pn = (wgid % nig) / gsz; return true;
    }
    __device__ __forceinline__ void a_ready(const Unit&) const {}
    __device__ __forceinline__ void done(const Unit&) const {}
};

template <class Epi, class Sched>
__device__ __forceinline__ void gemm_phase(PG8_LAS unsigned char* lds, const Gemm g, const Sched& S, const Epi& E, const int wave_s) {
    int tid_ = wave_s * 64 + (int)__builtin_amdgcn_mbcnt_hi(~0u, __builtin_amdgcn_mbcnt_lo(~0u, 0u)); const int tid = tid_, wid = __builtin_amdgcn_readfirstlane(tid >> 6), lane = tid & 63, wr = wid >> 2, wc = wid & 3, fr = lane & 15, fq = lane >> 4;
    const int K = g.K, nt = K / BK;
    unsigned voffA[2], voffB[2];
#pragma unroll
    for (int i = 0; i < 2; ++i) { int R, C; stage_rc(tid * 16 + i * 8192, R, C); const int Rb = Epi::PERM ? ((R & ~31) + perm32(R & 31)) : R;
        voffA[i] = (unsigned)(R * g.lda + C) * 2u; voffB[i] = (unsigned)(Rb * g.ldb + C) * 2u; }
    const size_t kstep = (size_t)(BK * 2);
    const size_t hstepA = (size_t)HALF * g.lda * 2, hstepB = (size_t)HALF * g.ldb * 2;
    const size_t tstepA = 2 * hstepA, tstepB = 2 * hstepB;
    const unsigned ldsw = (unsigned)wid * 1024u;
    const int aoff = lds_byte(wr * 64 + fr, fq * 8), boff = lds_byte(wc * 32 + fr, fq * 8);
#define PG8_SA(b, h) (((b) * 2 + (h)) * HTB)
#define PG8_SB(b, h) ((4 + (b) * 2 + (h)) * HTB)
#define PG8_STAGE(bufoff, gbase, voff) do { _Pragma("unroll") for (int _i = 0; _i < 2; ++_i) \
        __builtin_amdgcn_global_load_lds((const unsigned*)((const char*)(gbase) + (voff)[_i]), (PG8_LAS unsigned*)(lds + (bufoff) + ldsw + _i * 8192), 16, 0, 0); } while (0)
#define PG8_LDA(dst, b, h) do { _Pragma("unroll") for (int m = 0; m < 4; ++m) _Pragma("unroll") for (int k = 0; k < 2; ++k) dst[m][k] = *(const PG8_LAS bf16x8*)(lds + PG8_SA(b, h) + aoff + m * 2048 + k * 1024); } while (0)
#define PG8_LDB(dst, b, h) do { _Pragma("unroll") for (int n = 0; n < 2; ++n) _Pragma("unroll") for (int k = 0; k < 2; ++k) dst[n][k] = *(const PG8_LAS bf16x8*)(lds + PG8_SB(b, h) + boff + n * 2048 + k * 1024); } while (0)
#define PG8_MMA(ai, bj, At, Bt) do { __builtin_amdgcn_s_setprio(1); _Pragma("unroll") for (int m = 0; m < 4; ++m) _Pragma("unroll") for (int n = 0; n < 2; ++n) _Pragma("unroll") for (int k = 0; k < 2; ++k) \
        acc[ai][bj][m][n] = __builtin_amdgcn_mfma_f32_16x16x32_bf16(Bt[n][k], At[m][k], acc[ai][bj][m][n], 0, 0, 0); __builtin_amdgcn_s_setprio(0); } while (0)
#define PG8_WAIT_V(n) asm volatile("s_waitcnt vmcnt(" #n ")" ::: "memory")
#define PG8_WAIT_L(n) asm volatile("s_waitcnt lgkmcnt(" #n ")" ::: "memory")
#define PG8_BAR __builtin_amdgcn_s_barrier()
#define PG8_SCHED __builtin_amdgcn_sched_barrier(0)
    Unit cur, nxt; int ui = 0;
    if (!S.next(0, cur)) return;
    f32x4 acc[2][2][4][2];
#pragma unroll
    for (int a = 0; a < 2; ++a)
#pragma unroll
        for (int b = 0; b < 2; ++b)
#pragma unroll
            for (int m = 0; m < 4; ++m)
#pragma unroll
                for (int n = 0; n < 2; ++n) acc[a][b][m][n] = (f32x4){0.f, 0.f, 0.f, 0.f};
    bf16x8 At[4][2], B0[2][2], B1[2][2];
    const char* cA = (const char*)g.A + (size_t)cur.pm * tstepA + (size_t)cur.pn * g.a_pn_bytes; const char* cB = (const char*)g.Bt + (size_t)cur.pn * tstepB;
    S.a_ready(cur);
    PG8_STAGE(PG8_SB(0, 0), cB, voffB); PG8_STAGE(PG8_SA(0, 0), cA, voffA); PG8_STAGE(PG8_SB(0, 1), cB + hstepB, voffB); PG8_STAGE(PG8_SA(0, 1), cA + hstepA, voffA);
    if (wr == 1) PG8_BAR;
    PG8_WAIT_V(4); PG8_BAR;
    PG8_STAGE(PG8_SB(1, 0), cB + kstep, voffB); PG8_STAGE(PG8_SA(1, 0), cA + kstep, voffA); PG8_STAGE(PG8_SB(1, 1), cB + hstepB + kstep, voffB);
    PG8_WAIT_V(6); PG8_BAR;
    for (;;) {
        const bool has_next = S.next(ui + 1, nxt);
        const char* nA = has_next ? (const char*)g.A + (size_t)nxt.pm * tstepA + (size_t)nxt.pn * g.a_pn_bytes : cA; const char* nB = has_next ? (const char*)g.Bt + (size_t)nxt.pn * tstepB : cB;
        for (int t = 0; t < nt; t += 2) {
            const bool last = (t == nt - 2);
            const char* a1 = cA + (size_t)(t + 1) * kstep;
            const char* a2 = last ? nA : cA + (size_t)(t + 2) * kstep; const char* b2 = last ? nB : cB + (size_t)(t + 2) * kstep;
            const char* a3 = a2 + kstep; const char* b3 = b2 + kstep;
            if (last && has_next) S.a_ready(nxt);
            PG8_LDB(B0, 0, 0); PG8_SCHED; PG8_LDA(At, 0, 0); PG8_STAGE(PG8_SA(1, 1), a1 + hstepA, voffA);
            PG8_WAIT_L(8); PG8_BAR; PG8_WAIT_L(0); PG8_MMA(0, 0, At, B0); PG8_BAR; PG8_SCHED;
            PG8_LDB(B1, 0, 1); PG8_STAGE(PG8_SB(0, 0), b2, voffB);
            PG8_BAR; PG8_WAIT_L(0); PG8_MMA(0, 1, At, B1); PG8_BAR;
            PG8_LDA(At, 0, 1); PG8_STAGE(PG8_SA(0, 0), a2, voffA);
            PG8_BAR; PG8_WAIT_L(0); PG8_MMA(1, 0, At, B0); PG8_BAR; PG8_SCHED;
            PG8_STAGE(PG8_SB(0, 1), b2 + hstepB, voffB);
            PG8_WAIT_V(6); PG8_BAR; PG8_MMA(1, 1, At, B1); PG8_BAR;
            PG8_LDB(B0, 1, 0); PG8_SCHED; PG8_LDA(At, 1, 0); PG8_STAGE(PG8_SA(0, 1), a2 + hstepA, voffA);
            PG8_WAIT_L(8); PG8_BAR; PG8_WAIT_L(0); PG8_MMA(0, 0, At, B0); PG8_BAR; PG8_SCHED;
            PG8_LDB(B1, 1, 1); PG8_STAGE(PG8_SB(1, 0), b3, voffB);
            PG8_BAR; PG8_WAIT_L(0); PG8_MMA(0, 1, At, B1); PG8_BAR;
            PG8_LDA(At, 1, 1); PG8_STAGE(PG8_SA(1, 0), a3, voffA);
            PG8_BAR; PG8_WAIT_L(0); PG8_MMA(1, 0, At, B0); PG8_BAR; PG8_SCHED;
            PG8_STAGE(PG8_SB(1, 1), b3 + hstepB, voffB);
            PG8_WAIT_V(6); PG8_BAR; PG8_MMA(1, 1, At, B1); PG8_BAR;
        }
        if constexpr (!Epi::AFTER_DRAIN) { E(acc, cur, wr, wc, fr, fq); S.done(cur); }
        if (!has_next) break;
#pragma unroll
        for (int a = 0; a < 2; ++a)
#pragma unroll
            for (int b = 0; b < 2; ++b)
#pragma unroll
                for (int m = 0; m < 4; ++m)
#pragma unroll
                    for (int n = 0; n < 2; ++n) acc[a][b][m][n] = (f32x4){0.f, 0.f, 0.f, 0.f};
        cur = nxt; cA = nA; cB = nB; ++ui;
    }
    PG8_WAIT_V(0);
    if (wr == 0) PG8_BAR;
    PG8_BAR;
    if constexpr (Epi::AFTER_DRAIN) { E.fused(acc, cur, wr, wc, fr, fq, lds, wid, lane); S.done(cur); }
#undef PG8_SA
#undef PG8_SB
#undef PG8_STAGE
#undef PG8_LDA
#undef PG8_LDB
#undef PG8_MMA
#undef PG8_WAIT_V
#undef PG8_WAIT_L
#undef PG8_BAR
#undef PG8_SCHED
}
}

constexpr int BATCH = 8, SEQ = 2048, D = 1024, CTX = 256;
constexpr int MT = BATCH * SEQ;
constexpr int MC = BATCH * CTX;
constexpr int MA = MT + MC;
constexpr float EPS = 1e-6f;
constexpr int NPHASE = 12;
constexpr size_t MiB = 1u << 20;
constexpr size_t WS_MOD = 0;
constexpr size_t WS_LB = 512 * 1024;
constexpr size_t WS_BAR = 768 * 1024;
constexpr size_t WS_W0T = 1 * MiB;
constexpr size_t WS_W1T = 11 * MiB;
constexpr size_t WS_W2T = 13 * MiB;
constexpr size_t WS_WGT = 17 * MiB;
constexpr size_t WS_W3T = 18 * MiB;
constexpr size_t WS_FF = 20 * MiB;
constexpr size_t WS_FB = 56 * MiB;
constexpr size_t WS_V = 92 * MiB;
constexpr size_t WS_Q = 128 * MiB;
constexpr size_t WS_Z = 160 * MiB;
constexpr size_t WS_OB = 192 * MiB;
constexpr size_t WS_A1 = 20 * MiB;
constexpr size_t WS_X1 = 64 * MiB;
constexpr size_t WS_A2 = 128 * MiB;
constexpr size_t WS_U = 192 * MiB;
constexpr size_t WS_ZP = 160 * MiB;
constexpr size_t WS_A3 = 20 * MiB;
constexpr size_t WS_A4 = 128 * MiB;
constexpr size_t WS_PART = 52 * MiB;
constexpr size_t WS_END = 256 * MiB;
constexpr int BAR_CNT_WORD0 = 32768;
constexpr int BAR_BYTES = (32768 + 2 * 4096) * 4;

constexpr int LDS_BYTES = 131072 + 64;
constexpr int LDS_ST_OFF = 131072;

#define LAS __attribute__((address_space(3)))
typedef unsigned short bf16;
typedef unsigned v4u __attribute__((ext_vector_type(4)));
typedef unsigned v2u __attribute__((ext_vector_type(2)));
typedef float f32x4 __attribute__((ext_vector_type(4)));
typedef float f32x2 __attribute__((ext_vector_type(2)));
typedef short bf16x8 __attribute__((ext_vector_type(8)));
#define LDS_WAIT() asm volatile("s_waitcnt lgkmcnt(0)" ::: "memory")

typedef __bf16 bf16x2_t __attribute__((ext_vector_type(2)));
__device__ __forceinline__ unsigned pk2(float lo, float hi) { const bf16x2_t r = __builtin_convertvector((f32x2){lo, hi}, bf16x2_t); return __builtin_bit_cast(unsigned, r); }
__device__ __forceinline__ float bflo(unsigned u) { return __builtin_bit_cast(float, u << 16); }
__device__ __forceinline__ float bfhi(unsigned u) { return __builtin_bit_cast(float, u & 0xffff0000u); }
__device__ __forceinline__ float fast_rcp(float x) { return __builtin_amdgcn_rcpf(x); }
__device__ __forceinline__ float sigmoidf_(float x) { return fast_rcp(1.f + __expf(-x)); }
__device__ __forceinline__ float siluf_(float x) { return x * sigmoidf_(x); }
__device__ __forceinline__ float wave_sum(float v) {
#pragma unroll
    for (int o = 1; o < 64; o <<= 1) v += __shfl_xor(v, o);
    return v;
}


#define XB_TMO      128
#define XB_XCNT(j)  (256  + 64 * (j))
#define XB_XSUB(j)  (1280 + 64 * (j))
#define XB_XGEN(j)  (2304 + 64 * (j))
#define XB_TOP      3328
#define XB_TOPGEN   3392
#define XCD_BAR_WORDS 3456
#define XB_SPIN_CAP (1u << 18)
__device__ __forceinline__ unsigned xb_ld(unsigned* p)              { return __hip_atomic_load(p, __ATOMIC_RELAXED, __HIP_MEMORY_SCOPE_AGENT); }
__device__ __forceinline__ unsigned xb_add(unsigned* p, unsigned v) { return __hip_atomic_fetch_add(p, v, __ATOMIC_RELAXED, __HIP_MEMORY_SCOPE_AGENT); }
__device__ __forceinline__ unsigned xb_xcc_id() { return (unsigned)__builtin_amdgcn_s_getreg((3 << 11) | 20) & 0xFu; }
#define XB_SPIN(cond, bar) do { unsigned _sp = 0; while (cond) { __builtin_amdgcn_s_sleep(1); \
    if ((++_sp & 255u) == 0u) { if (xb_ld(&(bar)[XB_TMO])) break; if (_sp > XB_SPIN_CAP) { atomicAdd(&(bar)[XB_TMO], 1u); break; } } } } while (0)
__device__ __forceinline__ void xcd_barrier_complete(unsigned* bar, unsigned x, unsigned& nloc, unsigned& nx, const unsigned G) {
    unsigned sum, cnt, mine, sp = 0u;
    for (;;) {
        sum = 0u; cnt = 0u; mine = 0u;
#pragma unroll
        for (unsigned j = 0; j < 16; ++j) { const unsigned c = xb_ld(&bar[XB_XCNT(j)]); sum += c; cnt += (c > 0u) ? 1u : 0u; mine = (j == x) ? c : mine; }
        if (sum == G) break;
        __builtin_amdgcn_s_sleep(1);
        if ((++sp & 255u) == 0u) { if (xb_ld(&bar[XB_TMO])) break; if (sp > XB_SPIN_CAP) { atomicAdd(&bar[XB_TMO], 1u); break; } }
    }
    nloc = mine > 0u ? mine : 1u; nx = cnt > 0u ? cnt : 1u;
}
__device__ __forceinline__ void xcd_barrier(unsigned* bar, volatile LAS unsigned* st, const bool leader, const unsigned G) {
    asm volatile("s_waitcnt vmcnt(0)" ::: "memory");
    __syncthreads();
    if (leader) {
        const unsigned x = xb_xcc_id();
        __builtin_amdgcn_s_waitcnt(0);
        unsigned nloc = st[0], nx = st[1];
        if (nloc == 0u) { xcd_barrier_complete(bar, x, nloc, nx, G); st[0] = nloc; st[1] = nx; }
        const unsigned old = xb_add(&bar[XB_XSUB(x)], 1u);
        const unsigned gen = old / nloc;
        if (old + 1u == (gen + 1u) * nloc) {
            __builtin_amdgcn_fence(__ATOMIC_RELEASE, "agent");
            asm volatile("s_waitcnt vmcnt(0)" ::: "memory");
            const unsigned og = xb_add(&bar[XB_TOP], 1u);
            const unsigned tg = og / nx;
            if (og + 1u == (tg + 1u) * nx) xb_add(&bar[XB_TOPGEN], 1u);
            else XB_SPIN(xb_ld(&bar[XB_TOPGEN]) == tg, bar);
            __builtin_amdgcn_fence(__ATOMIC_ACQUIRE, "agent");
            xb_add(&bar[XB_XGEN(x)], 1u);
            asm volatile("s_waitcnt vmcnt(0)" ::: "memory");
        } else {
            XB_SPIN(xb_ld(&bar[XB_XGEN(x)]) == gen, bar);
            __builtin_amdgcn_fence(__ATOMIC_ACQUIRE, "agent");
            asm volatile("s_waitcnt vmcnt(0)" ::: "memory");
        }
    }
    __syncthreads();
}

struct Grp { int g, lb, nblk, ng; };

struct Args { const float* in[16]; float* out; unsigned char* ws; int ph_lo, ph_hi; };
#define GAS __attribute__((address_space(1)))
#define CAS __attribute__((address_space(4)))
__device__ __forceinline__ const unsigned char CAS* karg_base() { const unsigned char CAS* p = (const unsigned char CAS*)__builtin_amdgcn_kernarg_segment_ptr(); asm volatile("" : "+s"(p)); return p; }
__device__ __forceinline__ unsigned long long karg_u64(int off) { return *(const unsigned long long CAS*)(karg_base() + off); }
__device__ __forceinline__ int karg_i32(int off) { return *(const int CAS*)(karg_base() + off); }
#define KA_IN(i) ((const float*)(const float GAS*)karg_u64(8 * (i)))
#define KA_OUT() ((float*)(float GAS*)karg_u64(128))
#define KA_WS() ((unsigned char*)(unsigned char GAS*)karg_u64(136))
static_assert(sizeof(Args) == 152, "Args layout");

struct EpiInProj {
    static constexpr bool PERM = true, AFTER_DRAIN = false;
    unsigned char* ws; int row_off;
    __device__ __forceinline__ void operator()(const f32x4 (&acc)[2][2][4][2], const pg8::Unit& u, int wr, int wc, int fr, int fq) const {
        const int type = u.pn >> 2, colt = (u.pn & 3) * 256;
        const int row0 = row_off + u.pm * 256 + wr * 64 + fr, col0 = colt + wc * 32 + 8 * fq;
        if (type < 2) {
            bf16* F = (bf16*)(ws + (type == 0 ? WS_FF : WS_FB)); const float* lbp = (const float*)(ws + WS_LB) + type * 1024 + col0;
            f32x4 lv[2][2];
#pragma unroll
            for (int bj = 0; bj < 2; ++bj)
#pragma unroll
                for (int n = 0; n < 2; ++n) lv[bj][n] = *(const f32x4*)(lbp + bj * 128 + 4 * n);
#pragma unroll
            for (int ai = 0; ai < 2; ++ai)
#pragma unroll
                for (int m = 0; m < 4; ++m) { bf16* rowp = F + (size_t)(row0 + ai * 128 + m * 16) * 1024 + col0;
#pragma unroll
                    for (int bj = 0; bj < 2; ++bj) { unsigned o[4];
#pragma unroll
                        for (int n = 0; n < 2; ++n) { float q[4];
#pragma unroll
                            for (int e = 0; e < 4; ++e) { const float l = lv[bj][n][e]; const float f = l + (1.f - l) * sigmoidf_(acc[ai][bj][m][n][e]);
                                q[e] = __builtin_rintf(f * 65535.f); }
                            o[2 * n] = (unsigned)q[0] | ((unsigned)q[1] << 16); o[2 * n + 1] = (unsigned)q[2] | ((unsigned)q[3] << 16); }
                        *(v4u*)(rowp + bj * 128) = (v4u){o[0], o[1], o[2], o[3]}; } }
        } else {
            bf16* O = (bf16*)(ws + (type == 2 ? WS_V : (type == 3 ? WS_Q : WS_Z)));
            const float qs = type == 3 ? 0.08838834764831845f : 1.f;
#pragma unroll
            for (int ai = 0; ai < 2; ++ai)
#pragma unroll
                for (int m = 0; m < 4; ++m) { bf16* rowp = O + (size_t)(row0 + ai * 128 + m * 16) * 1024 + col0;
#pragma unroll
                    for (int bj = 0; bj < 2; ++bj) { f32x4 v0 = acc[ai][bj][m][0], v1 = acc[ai][bj][m][1];
                        if (type >= 3) {
#pragma unroll
                            for (int e = 0; e < 4; ++e) { v0[e] = siluf_(v0[e]) * qs; v1[e] = siluf_(v1[e]) * qs; } }
                        *(v4u*)(rowp + bj * 128) = (v4u){pk2(v0[0], v0[1]), pk2(v0[2], v0[3]), pk2(v1[0], v1[1]), pk2(v1[2], v1[3])}; } }
        }
    }
};
struct EpiResid {
    static constexpr bool PERM = false, AFTER_DRAIN = false;
    const float* xin; float* out; const float* gate;
    __device__ __forceinline__ void operator()(const f32x4 (&acc)[2][2][4][2], const pg8::Unit& u, int wr, int wc, int fr, int fq) const {
        const int row0 = u.pm * 256 + wr * 64 + fr, col0 = u.pn * 256 + wc * 32 + 4 * fq;
        const float* gp = gate + (size_t)(u.pm >> 3) * 3072 + col0;
        f32x4 gv[2][2];
#pragma unroll
        for (int bj = 0; bj < 2; ++bj)
#pragma unroll
            for (int n = 0; n < 2; ++n) gv[bj][n] = *(const f32x4*)(gp + bj * 128 + n * 16);
#pragma unroll
        for (int ai = 0; ai < 2; ++ai)
#pragma unroll
            for (int m = 0; m < 4; ++m) { const size_t ro = (size_t)(row0 + ai * 128 + m * 16) * 1024 + col0;
#pragma unroll
                for (int bj = 0; bj < 2; ++bj)
#pragma unroll
                    for (int n = 0; n < 2; ++n) { const f32x4 xv = *(const f32x4*)(xin + ro + bj * 128 + n * 16);
                        *(f32x4*)(out + ro + bj * 128 + n * 16) = xv + gv[bj][n] * acc[ai][bj][m][n]; } }
    }
};

template <int MODE> struct EpiResidNorm {
    static constexpr bool PERM = true, AFTER_DRAIN = true;
    const void* xin; void* xout; const float* gate; const float* nw; const float* mod; bf16* A2; float* part; unsigned* cnt; unsigned* bar;
    __device__ __forceinline__ void operator()(const f32x4 (&)[2][2][4][2], const pg8::Unit&, int, int, int, int) const {}
    __device__ __forceinline__ void fused(f32x4 (&acc)[2][2][4][2], const pg8::Unit& u, int wr, int wc, int fr, int fq, LAS unsigned char*, int wid, int lane) const {
        const int row0 = u.pm * 256 + wr * 64 + fr, col0 = u.pn * 256 + wc * 32 + 8 * fq;
        const float* gp = gate + (size_t)(u.pm >> 3) * 3072 + col0;
        float ss[2][4];
        f32x4 gv[2][2];
#pragma unroll
        for (int bj = 0; bj < 2; ++bj)
#pragma unroll
            for (int n = 0; n < 2; ++n) gv[bj][n] = *(const f32x4*)(gp + bj * 128 + 4 * n);
#pragma unroll
        for (int ai = 0; ai < 2; ++ai) {
            v4u xb[4][2]; f32x4 xf[4][2][2];
#pragma unroll
            for (int m = 0; m < 4; ++m)
#pragma unroll
                for (int bj = 0; bj < 2; ++bj) { const size_t ro = (size_t)(row0 + ai * 128 + m * 16) * 1024 + col0 + bj * 128;
                    if (MODE == 0) { xf[m][bj][0] = *(const f32x4*)((const float*)xin + ro); xf[m][bj][1] = *(const f32x4*)((const float*)xin + ro + 4); }
                    else xb[m][bj] = *(const v4u*)((const bf16*)xin + ro); }
#pragma unroll
            for (int m = 0; m < 4; ++m) { float s = 0.f;
#pragma unroll
                for (int bj = 0; bj < 2; ++bj) { f32x4 xv[2];
                    if (MODE == 0) { xv[0] = xf[m][bj][0]; xv[1] = xf[m][bj][1]; }
                    else { const v4u q = xb[m][bj]; xv[0] = (f32x4){bflo(q[0]), bfhi(q[0]), bflo(q[1]), bfhi(q[1])}; xv[1] = (f32x4){bflo(q[2]), bfhi(q[2]), bflo(q[3]), bfhi(q[3])}; }
#pragma unroll
                    for (int n = 0; n < 2; ++n) { const f32x4 v = xv[n] + gv[bj][n] * acc[ai][bj][m][n]; acc[ai][bj][m][n] = v; s += (v.x * v.x + v.y * v.y) + (v.z * v.z + v.w * v.w); } }
                s += __shfl_xor(s, 16); s += __shfl_xor(s, 32); ss[ai][m] = s; } }
        if (fq == 0) {
#pragma unroll
            for (int ai = 0; ai < 2; ++ai)
#pragma unroll
                for (int m = 0; m < 4; ++m) __hip_atomic_store((unsigned*)(part + (size_t)(row0 + ai * 128 + m * 16) * 16 + u.pn * 4 + wc), __builtin_bit_cast(unsigned, ss[ai][m]), __ATOMIC_RELAXED, __HIP_MEMORY_SCOPE_AGENT); }
        asm volatile("s_waitcnt vmcnt(0)" ::: "memory");
        __syncthreads();
        if (wid == 0 && lane == 0) (void)xb_add(cnt + 64 * u.pm, 1u);
        if (MODE == 0) {
#pragma unroll
            for (int ai = 0; ai < 2; ++ai)
#pragma unroll
                for (int m = 0; m < 4; ++m)
#pragma unroll
                    for (int bj = 0; bj < 2; ++bj) { const f32x4 v0 = acc[ai][bj][m][0], v1 = acc[ai][bj][m][1];
                        *(v4u*)((bf16*)xout + (size_t)(row0 + ai * 128 + m * 16) * 1024 + col0 + bj * 128) = (v4u){pk2(v0[0], v0[1]), pk2(v0[2], v0[3]), pk2(v1[0], v1[1]), pk2(v1[2], v1[3])}; } }
        if (wid == 0 && lane == 0) { unsigned* cw = cnt + 64 * u.pm; XB_SPIN(xb_ld(cw) < 4u, bar);
            __builtin_amdgcn_fence(__ATOMIC_ACQUIRE, "agent"); asm volatile("s_waitcnt vmcnt(0)" ::: "memory"); }
        __syncthreads();
        float rstd[2][4];
#pragma unroll
        for (int ai = 0; ai < 2; ++ai)
#pragma unroll
            for (int m = 0; m < 4; ++m) { unsigned* pp = (unsigned*)(part + (size_t)(row0 + ai * 128 + m * 16) * 16 + 4 * fq); float s = 0.f;
#pragma unroll
                for (int e = 0; e < 4; ++e) s += __builtin_bit_cast(float, __hip_atomic_load(pp + e, __ATOMIC_RELAXED, __HIP_MEMORY_SCOPE_AGENT));
                s += __shfl_xor(s, 16); s += __shfl_xor(s, 32);
                rstd[ai][m] = __builtin_amdgcn_rsqf(s * (1.f / 1024.f) + EPS); }
        if (MODE == 1) {
#pragma unroll
            for (int bj = 0; bj < 2; ++bj)
#pragma unroll
                for (int n = 0; n < 2; ++n) { const f32x4 w4 = *(const f32x4*)(nw + col0 + bj * 128 + 4 * n);
#pragma unroll
                    for (int ai = 0; ai < 2; ++ai)
#pragma unroll
                        for (int m = 0; m < 4; ++m) *(f32x4*)((float*)xout + (size_t)(row0 + ai * 128 + m * 16) * 1024 + col0 + bj * 128 + 4 * n) = acc[ai][bj][m][n] * rstd[ai][m] * w4; }
        } else {
            const float* mp = mod + (size_t)(u.pm >> 3) * 3072 + col0;
#pragma unroll
            for (int bj = 0; bj < 2; ++bj) { f32x4 g[2], sh[2];
#pragma unroll
                for (int n = 0; n < 2; ++n) { g[n] = *(const f32x4*)(nw + col0 + bj * 128 + 4 * n) * (*(const f32x4*)(mp + 1024 + bj * 128 + 4 * n) + 1.f); sh[n] = *(const f32x4*)(mp + bj * 128 + 4 * n); }
#pragma unroll
                for (int ai = 0; ai < 2; ++ai)
#pragma unroll
                    for (int m = 0; m < 4; ++m) { const f32x4 y0 = acc[ai][bj][m][0] * rstd[ai][m] * g[0] + sh[0], y1 = acc[ai][bj][m][1] * rstd[ai][m] * g[1] + sh[1];
                        *(v4u*)(A2 + (size_t)(row0 + ai * 128 + m * 16) * 1024 + col0 + bj * 128) = (v4u){pk2(y0[0], y0[1]), pk2(y0[2], y0[3]), pk2(y1[0], y1[1]), pk2(y1[2], y1[3])}; } }
        }
    }
};
struct EpiPoolIn {
    static constexpr bool PERM = true, AFTER_DRAIN = false;
    bf16* U; bf16* ZP;
    __device__ __forceinline__ void operator()(const f32x4 (&acc)[2][2][4][2], const pg8::Unit& u, int wr, int wc, int fr, int fq) const {
        const int type = u.pn >> 2, colt = (u.pn & 3) * 256;
        const int row0 = u.pm * 256 + wr * 64 + fr, col0 = colt + wc * 32 + 8 * fq;
#pragma unroll
        for (int ai = 0; ai < 2; ++ai)
#pragma unroll
            for (int m = 0; m < 4; ++m) { const size_t ro = (size_t)(row0 + ai * 128 + m * 16) * 1024 + col0;
#pragma unroll
                for (int bj = 0; bj < 2; ++bj) { f32x4 v0 = acc[ai][bj][m][0], v1 = acc[ai][bj][m][1];
                    if (type == 0) { *(v4u*)(U + ro + bj * 128) = (v4u){pk2(v0[0], v0[1]), pk2(v0[2], v0[3]), pk2(v1[0], v1[1]), pk2(v1[2], v1[3])}; }
                    else {
#pragma unroll
                        for (int e = 0; e < 4; ++e) { v0[e] = siluf_(v0[e]); v1[e] = siluf_(v1[e]); }
                        *(v4u*)(ZP + ro + bj * 128) = (v4u){pk2(v0[0], v0[1]), pk2(v0[2], v0[3]), pk2(v1[0], v1[1]), pk2(v1[2], v1[3])}; } } }
    }
};
struct EpiGrp {
    static constexpr bool PERM = true, AFTER_DRAIN = false;
    bf16* A4; const float* scale; const bf16* ZP;
    __device__ __forceinline__ void operator()(const f32x4 (&acc)[2][2][4][2], const pg8::Unit& u, int wr, int wc, int fr, int fq) const {
        const int row0 = u.pm * 256 + wr * 64 + fr, col0 = u.pn * 256 + wc * 32 + 8 * fq;
#pragma unroll
        for (int ai = 0; ai < 2; ++ai)
#pragma unroll
            for (int m = 0; m < 4; ++m) { const size_t ro = (size_t)(row0 + ai * 128 + m * 16) * 1024 + col0;
#pragma unroll
                for (int bj = 0; bj < 2; ++bj) { const v4u zz = *(const v4u*)(ZP + ro + bj * 128);
                    const f32x4 v0 = acc[ai][bj][m][0] * *(const f32x4*)(scale + col0 + bj * 128), v1 = acc[ai][bj][m][1] * *(const f32x4*)(scale + col0 + bj * 128 + 4);
                    *(v4u*)(A4 + ro + bj * 128) = (v4u){pk2(v0[0] * bflo(zz[0]), v0[1] * bfhi(zz[0])), pk2(v0[2] * bflo(zz[1]), v0[3] * bfhi(zz[1])),
                                                         pk2(v1[0] * bflo(zz[2]), v1[1] * bfhi(zz[2])), pk2(v1[2] * bflo(zz[3]), v1[3] * bfhi(zz[3]))}; } }
    }
};
__device__ __forceinline__ void transpose_item(const float* W, int K, int N, bf16* WT, int row_off, LAS float* scr, int item, int lane) {
    const int nblk = N / 32, kb = item / nblk, nb = item % nblk, k0 = 64 * kb, n0 = 32 * nb;
    float wv[32];
#pragma unroll
    for (int i = 0; i < 32; ++i) wv[i] = W[(size_t)(k0 + 2 * i + (lane >> 5)) * N + n0 + (lane & 31)];
#pragma unroll
    for (int i = 0; i < 32; ++i) scr[(2 * i + (lane >> 5)) * 33 + (lane & 31)] = wv[i];
    LDS_WAIT(); asm volatile("" ::: "memory");
    const int c = lane & 7;
#pragma unroll
    for (int j = 0; j < 4; ++j) { const int n = (lane >> 3) + 8 * j; const LAS float* s = scr + (8 * c) * 33 + n;
        v4u o; o.x = pk2(s[0 * 33], s[1 * 33]); o.y = pk2(s[2 * 33], s[3 * 33]); o.z = pk2(s[4 * 33], s[5 * 33]); o.w = pk2(s[6 * 33], s[7 * 33]);
        *(v4u*)(WT + (size_t)(row_off + n0 + n) * K + k0 + 8 * c) = o; }
    LDS_WAIT(); asm volatile("" ::: "memory");
}

__device__ __forceinline__ void phase_late_weights(LAS unsigned char* lds, const int wave_s, const int gw, const int NGW) {
    const int lane = (int)__builtin_amdgcn_mbcnt_hi(~0u, __builtin_amdgcn_mbcnt_lo(~0u, 0u));
    LAS float* scr = (LAS float*)(lds + wave_s * 8448);
    constexpr int I1 = 16 * 32, I2 = 16 * 64, IG = 4 * 8, I3 = 16 * 32;
    constexpr int NIT = I1 + I2 + 4 * IG + I3;
    for (int it = gw; it < NIT; it += NGW) {
        int r = it;
        if (r < I1) { transpose_item(KA_IN(10), 1024, 1024, (bf16*)(KA_WS() + WS_W1T), 0, scr, r, lane); continue; } r -= I1;
        if (r < I2) { transpose_item(KA_IN(11), 1024, 2048, (bf16*)(KA_WS() + WS_W2T), 0, scr, r, lane); continue; } r -= I2;
        if (r < 4 * IG) { const int g = r / IG; transpose_item(KA_IN(12) + (size_t)g * 65536, 256, 256, (bf16*)(KA_WS() + WS_WGT), g * 256, scr, r % IG, lane); continue; } r -= 4 * IG;
        transpose_item(KA_IN(14), 1024, 1024, (bf16*)(KA_WS() + WS_W3T), 0, scr, r, lane);
    }
}

__device__ __forceinline__ void phase_prologue(const Args& a, LAS unsigned char* lds, const int wave_s) {
    int tid_ = wave_s * 64 + (int)__builtin_amdgcn_mbcnt_hi(~0u, __builtin_amdgcn_mbcnt_lo(~0u, 0u)); const int tid = tid_, lane = tid & 63, wave = __builtin_amdgcn_readfirstlane(tid >> 6);
    const float* c = KA_IN(1); const float* cctx = KA_IN(3); const float* ada_w = KA_IN(4); const float* ada_b = KA_IN(5);
    float* MOD = (float*)(KA_WS() + WS_MOD);
    LAS float* sil = (LAS float*)(lds + 69632);
    LAS float* red = sil + 9 * 1024;
    bool have_sil = false;
    for (int task = blockIdx.x; task < 192; task += gridDim.x) {
        if (!have_sil) {
            for (int i = tid; i < 9 * 1024; i += 512) { const float v = i < 8192 ? c[i] : cctx[i - 8192]; sil[i] = siluf_(v); }
            have_sil = true;
        }
        __syncthreads();
        const int l = task / 96, n0 = (task % 96) * 32;
        const float* W = ada_w + (size_t)l * 1024 * 3072 + n0 + (lane & 31);
        float acc[9];
#pragma unroll
        for (int r = 0; r < 9; ++r) acc[r] = 0.f;
        const int kb = wave * 128 + (lane >> 5);
#pragma unroll
        for (int i0 = 0; i0 < 64; i0 += 32) { float wv[32];
#pragma unroll
            for (int i = 0; i < 32; ++i) wv[i] = W[(size_t)(kb + 2 * (i0 + i)) * 3072];
#pragma unroll
            for (int i = 0; i < 32; ++i) { const int k = kb + 2 * (i0 + i);
#pragma unroll
                for (int r = 0; r < 9; ++r) acc[r] += sil[r * 1024 + k] * wv[i]; } }
#pragma unroll
        for (int r = 0; r < 9; ++r) acc[r] += __shfl_xor(acc[r], 32);
        if (lane < 32) {
#pragma unroll
            for (int r = 0; r < 9; ++r) red[(wave * 9 + r) * 32 + lane] = acc[r]; }
        __syncthreads();
        if (tid < 288) { const int r = tid >> 5, n = tid & 31; float s = 0.f;
#pragma unroll
            for (int w = 0; w < 8; ++w) s += red[(w * 9 + r) * 32 + n];
            MOD[(size_t)(l * 9 + r) * 3072 + n0 + n] = s + ada_b[l * 3072 + n0 + n]; }
    }
    if (blockIdx.x == gridDim.x - 1) { const float* lg = KA_IN(8); float* LB = (float*)(KA_WS() + WS_LB);
        for (int i = tid; i < 2048; i += 512) LB[i] = sigmoidf_(lg[i]); }
    LAS float* scr = (LAS float*)(lds + wave * 8448);
    const int gw = blockIdx.x * 8 + wave, NGW = gridDim.x * 8;
    constexpr int I0 = 16 * 160;
    for (int it = gw; it < I0; it += NGW) transpose_item(KA_IN(7), 1024, 5120, (bf16*)(KA_WS() + WS_W0T), 0, scr, it, lane);
    if (gridDim.x != 256) phase_late_weights(lds, wave_s, gw, NGW);
}

template <int R> __device__ __forceinline__ void modnorm_rows(const float* xrow0, const float* nw, const float* mod, bf16* orow0, int lane) {
    f32x4 v[R][4]; float rstd[R];
#pragma unroll
    for (int r = 0; r < R; ++r)
#pragma unroll
        for (int j = 0; j < 4; ++j) v[r][j] = ((const f32x4*)(xrow0 + (size_t)r * 1024))[lane + 64 * j];
#pragma unroll
    for (int r = 0; r < R; ++r) { float s = 0.f;
#pragma unroll
        for (int j = 0; j < 4; ++j) s += (v[r][j].x * v[r][j].x + v[r][j].y * v[r][j].y) + (v[r][j].z * v[r][j].z + v[r][j].w * v[r][j].w);
        rstd[r] = __builtin_amdgcn_rsqf(wave_sum(s) * (1.f / 1024.f) + EPS); }
#pragma unroll
    for (int j = 0; j < 4; ++j) { const f32x4 w4 = ((const f32x4*)nw)[lane + 64 * j], sh = ((const f32x4*)mod)[lane + 64 * j], sc = ((const f32x4*)(mod + 1024))[lane + 64 * j];
        const f32x4 g = w4 * (sc + 1.f);
#pragma unroll
        for (int r = 0; r < R; ++r) { const f32x4 y = v[r][j] * rstd[r] * g + sh;
            ((unsigned long long*)(orow0 + (size_t)r * 1024))[lane + 64 * j] = (unsigned long long)pk2(y.x, y.y) | ((unsigned long long)pk2(y.z, y.w) << 32); } }
}
__device__ __forceinline__ void phase_modnorm(const Args& a, int layer, const float* xsrc, int nrows_x, bf16* dst, const int wave_s, const Grp gp) {
    const int lane = (int)__builtin_amdgcn_mbcnt_hi(~0u, __builtin_amdgcn_mbcnt_lo(~0u, 0u)), wave = wave_s;
    const int gw = gp.lb * 8 + wave, NGW = gp.nblk * 8;
    const float* MOD = (const float*)(KA_WS() + WS_MOD) + (size_t)layer * 9 * 3072;
    const float* nw = KA_IN(6) + layer * 1024;
    for (int b = gp.g; b < BATCH; b += gp.ng) {
        for (int r = gw * 4; r < SEQ; r += NGW * 4) { const int m = b * SEQ + r; modnorm_rows<4>(xsrc + (size_t)m * 1024, nw, MOD + (size_t)b * 3072, dst + (size_t)m * 1024, lane); }
        if (layer == 0) { const float* cx = KA_IN(2);
            for (int r = gw; r < CTX; r += NGW) { const int m = b * CTX + r; modnorm_rows<1>(cx + (size_t)m * 1024, nw, MOD + (size_t)8 * 3072, dst + (size_t)(MT + m) * 1024, lane); } }
    }
}
__device__ __forceinline__ void phase_headnorm(const Args& a, const int wave_s, const Grp gp) {
    const int lane = (int)__builtin_amdgcn_mbcnt_hi(~0u, __builtin_amdgcn_mbcnt_lo(~0u, 0u)), wave = wave_s;
    const int gw = gp.lb * 8 + wave, NGW = gp.nblk * 8;
    const bf16* OF = (const bf16*)KA_OUT(); const bf16* OB = (const bf16*)(KA_WS() + WS_OB); const bf16* Z = (const bf16*)(KA_WS() + WS_Z); bf16* A1 = (bf16*)(KA_WS() + WS_A1);
    const float* gwt = KA_IN(9);
    constexpr int R = 4;
    for (int b = gp.g; b < BATCH; b += gp.ng)
    for (int rr = gw * R; rr < SEQ; rr += NGW * R) { const int m = b * SEQ + rr;
        v4u of[R][2], ob[R][2], zz[R][2];
#pragma unroll
        for (int r = 0; r < R; ++r)
#pragma unroll
            for (int j = 0; j < 2; ++j) { const size_t o = (size_t)(m + r) * 1024 + 512 * j + 8 * lane;
                of[r][j] = *(const v4u*)(OF + o); ob[r][j] = *(const v4u*)(OB + o); zz[r][j] = *(const v4u*)(Z + o); }
#pragma unroll
        for (int j = 0; j < 2; ++j) { const f32x4 w0 = *(const f32x4*)(gwt + 512 * j + 8 * lane), w1 = *(const f32x4*)(gwt + 512 * j + 8 * lane + 4);
#pragma unroll
            for (int r = 0; r < R; ++r) { float o[8]; float s = 0.f;
#pragma unroll
                for (int e = 0; e < 4; ++e) { o[2 * e] = bflo(of[r][j][e]) + bflo(ob[r][j][e]); o[2 * e + 1] = bfhi(of[r][j][e]) + bfhi(ob[r][j][e]); s += o[2 * e] * o[2 * e] + o[2 * e + 1] * o[2 * e + 1]; }
#pragma unroll
                for (int sh = 1; sh < 16; sh <<= 1) s += __shfl_xor(s, sh);
                const float rstd = __builtin_amdgcn_rsqf(s * (1.f / 128.f) + EPS);
                v4u out;
#pragma unroll
                for (int e = 0; e < 4; ++e) { const float wa = e < 2 ? w0[2 * e] : w1[2 * e - 4], wb = e < 2 ? w0[2 * e + 1] : w1[2 * e - 3];
                    out[e] = pk2(o[2 * e] * rstd * wa * bflo(zz[r][j][e]), o[2 * e + 1] * rstd * wb * bfhi(zz[r][j][e])); }
                *(v4u*)(A1 + (size_t)(m + r) * 1024 + 512 * j + 8 * lane) = out; } }
    }
}
__device__ __forceinline__ void phase_pool(const Args& a, LAS unsigned char* lds, const int wave_s) {
    int tid_ = wave_s * 64 + (int)__builtin_amdgcn_mbcnt_hi(~0u, __builtin_amdgcn_mbcnt_lo(~0u, 0u)); const int tid = tid_;
    const bf16* Ub = (const bf16*)(KA_WS() + WS_U); bf16* A3 = (bf16*)(KA_WS() + WS_A3);
    v4u pre[4];
    int unit = blockIdx.x, buf = 0;
#define POOL_LOAD(un) do { const bf16* U_ = Ub + (size_t)((un) >> 2) * 64 * 1024 + ((un) & 3) * 256; \
        _Pragma("unroll") for (int i = 0; i < 4; ++i) { const int idx = tid + 512 * i; pre[i] = *(const v4u*)(U_ + (size_t)(idx >> 5) * 1024 + 8 * (idx & 31)); } } while (0)
    if (unit < 1024) POOL_LOAD(unit);
    for (; unit < 1024; unit += gridDim.x, buf ^= 1) {
        LAS float* T = (LAS float*)(lds + buf * 65536);
#pragma unroll
        for (int i = 0; i < 4; ++i) { const int idx = tid + 512 * i; LAS float* tp = T + (idx >> 5) * 256 + 8 * (idx & 31);
            *(LAS f32x4*)tp = (f32x4){bflo(pre[i][0]), bfhi(pre[i][0]), bflo(pre[i][1]), bfhi(pre[i][1])};
            *(LAS f32x4*)(tp + 4) = (f32x4){bflo(pre[i][2]), bfhi(pre[i][2]), bflo(pre[i][3]), bfhi(pre[i][3])}; }
        __syncthreads();
        if (unit + (int)gridDim.x < 1024) POOL_LOAD(unit + gridDim.x);
        const int g = unit & 3, br = unit >> 2;
        const int c = 2 * (tid & 127), t0 = (tid >> 7) * 16, hw = 1 << g;
        int lo = max(t0 - hw, 0), hi = min(t0 + hw, 64); f32x2 s = (f32x2){0.f, 0.f};
        for (int j = lo; j < hi; ++j) s += *(const LAS f32x2*)(T + j * 256 + c);
        bf16* op = A3 + (size_t)(br * 64) * 1024 + g * 256 + c;
#pragma unroll 4
        for (int t = t0; t < t0 + 16; ++t) {
            if (t > t0) { const int nlo = max(t - hw, 0), nhi = min(t + hw, 64);
                if (nhi > hi) s += *(const LAS f32x2*)(T + (nhi - 1) * 256 + c);
                if (nlo > lo) s -= *(const LAS f32x2*)(T + lo * 256 + c);
                lo = nlo; hi = nhi; }
            const float inv = fast_rcp((float)(hi - lo)); const f32x2 ctr = *(const LAS f32x2*)(T + t * 256 + c);
            *(unsigned*)(op + (size_t)t * 1024) = pk2(s.x * inv - ctr.x, s.y * inv - ctr.y);
        }
    }
    __syncthreads();
#undef POOL_LOAD
}
__device__ __forceinline__ void phase_final(const Args& a, const int wave_s) {
    int tid_ = wave_s * 64 + (int)__builtin_amdgcn_mbcnt_hi(~0u, __builtin_amdgcn_mbcnt_lo(~0u, 0u)); const int lane = tid_ & 63, wave = tid_ >> 6;
    const int gw = blockIdx.x * 8 + wave, NGW = gridDim.x * 8;
    const float* fw = KA_IN(15); float* out = KA_OUT();
    constexpr int R = 4;
    for (int m = gw * R; m < MT; m += NGW * R) {
        f32x4 v[R][4]; float rstd[R];
#pragma unroll
        for (int r = 0; r < R; ++r)
#pragma unroll
            for (int j = 0; j < 4; ++j) v[r][j] = ((const f32x4*)(out + (size_t)(m + r) * 1024))[lane + 64 * j];
#pragma unroll
        for (int r = 0; r < R; ++r) { float s = 0.f;
#pragma unroll
            for (int j = 0; j < 4; ++j) s += (v[r][j].x * v[r][j].x + v[r][j].y * v[r][j].y) + (v[r][j].z * v[r][j].z + v[r][j].w * v[r][j].w);
            rstd[r] = __builtin_amdgcn_rsqf(wave_sum(s) * (1.f / 1024.f) + EPS); }
#pragma unroll
        for (int j = 0; j < 4; ++j) { const f32x4 w4 = ((const f32x4*)fw)[lane + 64 * j];
#pragma unroll
            for (int r = 0; r < R; ++r) ((f32x4*)(out + (size_t)(m + r) * 1024))[lane + 64 * j] = v[r][j] * rstd[r] * w4; }
    }
}
constexpr int QS_OFF = 0, KS_OFF = 17408, KST_OFF = 34816, VT_OFF = 53248, SPT_OFF = 62464, TOT_OFF = 79872;
__device__ __forceinline__ f32x4 mfma16(bf16x8 a, bf16x8 b, f32x4 c) { return __builtin_amdgcn_mfma_f32_16x16x32_bf16(a, b, c, 0, 0, 0); }
__device__ __forceinline__ bf16x8 as_bf16x8(v4u v) { return __builtin_bit_cast(bf16x8, v); }

struct GlaRegs { unsigned f[8], q[8], v[8]; };
struct GlaCtx { const bf16* Fq; const bf16* Qb; const bf16* Vb; bf16* O; int b, h, dir, vs, w, lane, fr, fq; };
__device__ __forceinline__ int gla_rowbase(const GlaCtx& c, int i) { return i < 4 ? (MT + c.b * 256 + (c.dir ? 3 - i : i) * 64) : (c.b * 2048 + (c.dir ? 35 - i : i - 4) * 64); }
template <bool WITH_Q> __device__ __forceinline__ void gla_load(GlaRegs& R, const GlaCtx& c, int i) {
    const int rb = gla_rowbase(c, i);
#pragma unroll
    for (int jj = 0; jj < 8; ++jj) { const int r = 8 * c.w + jj; const size_t g = (size_t)(rb + (c.dir ? 63 - r : r)) * 1024 + c.h * 128;
        R.f[jj] = *(const unsigned*)(c.Fq + g + 2 * c.lane);
        if (WITH_Q) R.q[jj] = *(const unsigned*)(c.Qb + g + 2 * c.lane);
        R.v[jj] = *(const unsigned*)(c.Vb + g + c.vs * 64 + 2 * (c.lane & 31)); }
}
template <bool OUT, bool NEXT_Q> __device__ __forceinline__ void gla_step(GlaRegs& R, const GlaCtx& c, const int i, const int inext, f32x4 (&S)[4], LAS unsigned char* lds) {
    LAS unsigned char* QS = lds + QS_OFF; LAS unsigned char* KS = lds + KS_OFF; LAS unsigned char* KST = lds + KST_OFF;
    LAS unsigned char* VT = lds + VT_OFF; LAS unsigned char* SPT = lds + SPT_OFF; LAS float* TOT = (LAS float*)(lds + TOT_OFF);
    const int w = c.w, lane = c.lane, fr = c.fr, fq = c.fq, ci = w & 3, vh = w >> 2;
    constexpr bool has_out = OUT;
    float f0[8], f1[8], p0[8], p1[8]; float run0 = 1.f, run1 = 1.f;
#pragma unroll
    for (int jj = 0; jj < 8; ++jj) { f0[jj] = (float)(R.f[jj] & 0xffffu) * (1.f / 65535.f); f1[jj] = (float)(R.f[jj] >> 16) * (1.f / 65535.f);
        run0 *= f0[jj]; run1 *= f1[jj]; p0[jj] = run0; p1[jj] = run1; }
    *(LAS f32x2*)(TOT + w * 128 + 2 * lane) = (f32x2){run0, run1};
    __syncthreads();
    float pre0 = 1.f, pre1 = 1.f, mid0 = 1.f, mid1 = 1.f;
#pragma unroll
    for (int j = 0; j < 8; ++j) { const f32x2 t = *(const LAS f32x2*)(TOT + j * 128 + 2 * lane);
        pre0 *= (j < w) ? t.x : 1.f; pre1 *= (j < w) ? t.y : 1.f; if (j < 4) { mid0 *= t.x; mid1 *= t.y; } }
    const float rmid0 = fast_rcp(mid0), rmid1 = fast_rcp(mid1);
    unsigned kt0[4], kt1[4];
#pragma unroll
    for (int jj = 0; jj < 8; jj += 2) {
        float ka[2], kb[2];
#pragma unroll
        for (int e = 0; e < 2; ++e) { const int j2 = jj + e;
            const float pc0 = p0[j2] * pre0, pc1 = p1[j2] * pre1;
            const float ks0 = (1.f - f0[j2]) * mid0 * fast_rcp(pc0), ks1 = (1.f - f1[j2]) * mid1 * fast_rcp(pc1);
            ka[e] = ks0; kb[e] = ks1;
            if (has_out) {
                *(LAS unsigned*)(KS + (8 * w + j2) * 272 + 4 * lane) = pk2(ks0, ks1);
                const float qs0 = bflo(R.q[j2]) * pc0 * rmid0, qs1 = bfhi(R.q[j2]) * pc1 * rmid1;
                *(LAS unsigned*)(QS + (8 * w + j2) * 272 + 4 * lane) = pk2(qs0, qs1); } }
        kt0[jj >> 1] = pk2(ka[0], ka[1]); kt1[jj >> 1] = pk2(kb[0], kb[1]); }
    *(LAS v4u*)(KST + (2 * lane) * 144 + 16 * w) = (v4u){kt0[0], kt0[1], kt0[2], kt0[3]};
    *(LAS v4u*)(KST + (2 * lane + 1) * 144 + 16 * w) = (v4u){kt1[0], kt1[1], kt1[2], kt1[3]};
    if (lane < 32) {
        *(LAS v4u*)(VT + (2 * lane) * 144 + 16 * w) = (v4u){__builtin_amdgcn_perm(R.v[1], R.v[0], 0x05040100u), __builtin_amdgcn_perm(R.v[3], R.v[2], 0x05040100u), __builtin_amdgcn_perm(R.v[5], R.v[4], 0x05040100u), __builtin_amdgcn_perm(R.v[7], R.v[6], 0x05040100u)};
        *(LAS v4u*)(VT + (2 * lane + 1) * 144 + 16 * w) = (v4u){__builtin_amdgcn_perm(R.v[1], R.v[0], 0x07060302u), __builtin_amdgcn_perm(R.v[3], R.v[2], 0x07060302u), __builtin_amdgcn_perm(R.v[5], R.v[4], 0x07060302u), __builtin_amdgcn_perm(R.v[7], R.v[6], 0x07060302u)}; }
    f32x4 pm4 = (f32x4){1.f, 1.f, 1.f, 1.f}, pl4 = pm4;
#pragma unroll
    for (int j = 0; j < 8; ++j) { const f32x4 t = *(const LAS f32x4*)(TOT + j * 128 + 16 * w + 4 * fq); pl4 *= t; if (j < 4) pm4 *= t; }
    if (has_out) {
#pragma unroll
        for (int vb = 0; vb < 4; ++vb) { const f32x4 sp = pm4 * S[vb];
            *(LAS v2u*)(SPT + (16 * vb + fr) * 272 + (16 * w + 4 * fq) * 2) = (v2u){pk2(sp[0], sp[1]), pk2(sp[2], sp[3])}; } }
    gla_load<NEXT_Q>(R, c, inext);
    __syncthreads();
    if (has_out) {
        bf16x8 qf[4];
#pragma unroll
        for (int kk = 0; kk < 4; ++kk) qf[kk] = *(const LAS bf16x8*)(QS + (16 * ci + fr) * 272 + (32 * kk + 8 * fq) * 2);
        f32x4 at[4];
#pragma unroll
        for (int sb = 0; sb < 4; ++sb) { at[sb] = (f32x4){0.f, 0.f, 0.f, 0.f};
            if (sb <= ci) {
#pragma unroll
                for (int kk = 0; kk < 4; ++kk) { const bf16x8 kf = *(const LAS bf16x8*)(KS + (16 * sb + fr) * 272 + (32 * kk + 8 * fq) * 2); at[sb] = mfma16(kf, qf[kk], at[sb]); }
                if (sb == ci) {
#pragma unroll
                    for (int jj = 0; jj < 4; ++jj) at[sb][jj] = (4 * fq + jj <= fr) ? at[sb][jj] : 0.f; } } }
        f32x4 oacc[2]; oacc[0] = (f32x4){0.f, 0.f, 0.f, 0.f}; oacc[1] = oacc[0];
#pragma unroll
        for (int k2 = 0; k2 < 2; ++k2) {
            if (2 * k2 <= ci) {
                const bf16x8 pb = as_bf16x8((v4u){pk2(at[2 * k2][0], at[2 * k2][1]), pk2(at[2 * k2][2], at[2 * k2][3]), pk2(at[2 * k2 + 1][0], at[2 * k2 + 1][1]), pk2(at[2 * k2 + 1][2], at[2 * k2 + 1][3])});
#pragma unroll
                for (int vt = 0; vt < 2; ++vt) { const LAS unsigned char* vp = VT + (16 * (2 * vh + vt) + fr) * 144 + (32 * k2 + 4 * fq) * 2;
                    const v2u lo = *(const LAS v2u*)vp, hi = *(const LAS v2u*)(vp + 32);
                    oacc[vt] = mfma16(as_bf16x8((v4u){lo[0], lo[1], hi[0], hi[1]}), pb, oacc[vt]); } } }
#pragma unroll
        for (int kk = 0; kk < 4; ++kk)
#pragma unroll
            for (int vt = 0; vt < 2; ++vt) { const bf16x8 sf = *(const LAS bf16x8*)(SPT + (16 * (2 * vh + vt) + fr) * 272 + (32 * kk + 8 * fq) * 2); oacc[vt] = mfma16(sf, qf[kk], oacc[vt]); }
        const int r = 16 * ci + fr; const size_t go = (size_t)(gla_rowbase(c, i) + (c.dir ? 63 - r : r)) * 1024 + c.h * 128 + c.vs * 64 + 4 * fq;
#pragma unroll
        for (int vt = 0; vt < 2; ++vt) *(v2u*)(c.O + go + 16 * (2 * vh + vt)) = (v2u){pk2(oacc[vt][0], oacc[vt][1]), pk2(oacc[vt][2], oacc[vt][3])};
    }
    {
        bf16x8 ka[2];
#pragma unroll
        for (int ss = 0; ss < 2; ++ss) ka[ss] = *(const LAS bf16x8*)(KST + (16 * w + fr) * 144 + (32 * ss + 8 * fq) * 2);
        f32x4 sc;
#pragma unroll
        for (int e = 0; e < 4; ++e) sc[e] = pl4[e] * fast_rcp(pm4[e]);
#pragma unroll
        for (int vb = 0; vb < 4; ++vb) { f32x4 uu = (f32x4){0.f, 0.f, 0.f, 0.f};
#pragma unroll
            for (int ss = 0; ss < 2; ++ss) { const bf16x8 vf = *(const LAS bf16x8*)(VT + (16 * vb + fr) * 144 + (32 * ss + 8 * fq) * 2); uu = mfma16(ka[ss], vf, uu); }
            S[vb] = pl4 * S[vb] + sc * uu; }
    }
}
__device__ __forceinline__ void phase_gla(const Args& a, LAS unsigned char* lds, const int wave_s, const Grp gp) {
    int tid_ = wave_s * 64 + (int)__builtin_amdgcn_mbcnt_hi(~0u, __builtin_amdgcn_mbcnt_lo(~0u, 0u)); const int tid = tid_, lane = tid & 63, w = __builtin_amdgcn_readfirstlane(tid >> 6);
    unsigned char* ws = KA_WS();
    for (int b = gp.g; b < BATCH; b += gp.ng)
    for (int lu = gp.lb; lu < 32; lu += gp.nblk) {
        const int h = lu & 7, dir = (lu >> 3) & 1, vs = lu >> 4;
        GlaCtx c; c.Fq = (const bf16*)(ws + (dir ? WS_FB : WS_FF)); c.Qb = (const bf16*)(ws + WS_Q); c.Vb = (const bf16*)(ws + WS_V);
        c.O = dir ? (bf16*)(ws + WS_OB) : (bf16*)KA_OUT(); c.b = b; c.h = h; c.dir = dir; c.vs = vs; c.w = w; c.lane = lane; c.fr = lane & 15; c.fq = lane >> 4;
        f32x4 S[4];
#pragma unroll
        for (int i = 0; i < 4; ++i) S[i] = (f32x4){0.f, 0.f, 0.f, 0.f};
        GlaRegs RA, RB;
        gla_load<false>(RA, c, 0); gla_load<false>(RB, c, 1);
        gla_step<false, false>(RA, c, 0, 2, S, lds); gla_step<false, false>(RB, c, 1, 3, S, lds);
        gla_step<false, true>(RA, c, 2, 4, S, lds); gla_step<false, true>(RB, c, 3, 5, S, lds);
        for (int i = 4; i < 36; i += 2) { gla_step<true, true>(RA, c, i, min(i + 2, 35), S, lds); gla_step<true, true>(RB, c, i + 1, min(i + 3, 35), S, lds); }
        __syncthreads();
    }
}

__device__ __forceinline__ void phase_pool_grp(LAS unsigned char* lds, const int wave_s, const Grp gp) {
    int tid_ = wave_s * 64 + (int)__builtin_amdgcn_mbcnt_hi(~0u, __builtin_amdgcn_mbcnt_lo(~0u, 0u)); const int tid = tid_, lane = tid & 63, w = wave_s, fr = lane & 15, fq = lane >> 4;
    unsigned char* ws = KA_WS();
    const bf16* Ub = (const bf16*)(ws + WS_U); const bf16* ZP = (const bf16*)(ws + WS_ZP); const bf16* WG = (const bf16*)(ws + WS_WGT); bf16* A4 = (bf16*)(ws + WS_A4);
    const float* scale = KA_IN(13);
    LAS unsigned char* P = lds + 65536;
    v4u pre[4]; bf16x8 bfr[2][8]; int gcur = -1;
    const int upb = (128 - gp.lb + gp.nblk - 1) / gp.nblk;
    const int nun = upb * ((BATCH - gp.g + gp.ng - 1) / gp.ng);
#define POOL_UNIT(k) (((gp.g + ((k) / upb) * gp.ng) * 32) * 4 + gp.lb + ((k) % upb) * gp.nblk)
    int kun = 0, buf = 0;
#define POOL_LOAD(un) do { const bf16* U_ = Ub + (size_t)((un) >> 2) * 64 * 1024 + ((un) & 3) * 256; \
        _Pragma("unroll") for (int i = 0; i < 4; ++i) { const int idx = tid + 512 * i; pre[i] = *(const v4u*)(U_ + (size_t)(idx >> 5) * 1024 + 8 * (idx & 31)); } } while (0)
    if (kun < nun) POOL_LOAD(POOL_UNIT(kun));
    for (; kun < nun; ++kun, buf ^= 1) { const int unit = POOL_UNIT(kun);
        LAS unsigned char* T = lds + buf * 32768;
#pragma unroll
        for (int i = 0; i < 4; ++i) { const int idx = tid + 512 * i; *(LAS v4u*)(T + (idx >> 5) * 512 + 16 * (idx & 31)) = pre[i]; }
        __syncthreads();
        if (kun + 1 < nun) POOL_LOAD(POOL_UNIT(kun + 1));
        const int g = unit & 3, br = unit >> 2;
        if (g != gcur) { gcur = g;
#pragma unroll
            for (int nt = 0; nt < 2; ++nt)
#pragma unroll
                for (int kk = 0; kk < 8; ++kk) { const int ncol = 32 * w + 8 * (fr >> 2) + 4 * nt + (fr & 3);
                    bfr[nt][kk] = *(const bf16x8*)(WG + (size_t)(g * 256 + ncol) * 256 + 32 * kk + 8 * fq); } }
        const int colb = g * 256 + 32 * w + 8 * fq;
        v4u zz[4];
#pragma unroll
        for (int mt = 0; mt < 4; ++mt) zz[mt] = *(const v4u*)(ZP + (size_t)(br * 64 + 16 * mt + fr) * 1024 + colb);
        {
            const int cp = tid & 127, t0 = (tid >> 7) * 16, hw = 1 << g;
            int lo = max(t0 - hw, 0), hi = min(t0 + hw, 64); f32x2 s = (f32x2){0.f, 0.f};
            for (int j = lo; j < hi; ++j) { const unsigned d = *(const LAS unsigned*)(T + j * 512 + 4 * cp); s.x += bflo(d); s.y += bfhi(d); }
#pragma unroll 4
            for (int t = t0; t < t0 + 16; ++t) {
                if (t > t0) { const int nlo = max(t - hw, 0), nhi = min(t + hw, 64);
                    if (nhi > hi) { const unsigned d = *(const LAS unsigned*)(T + (nhi - 1) * 512 + 4 * cp); s.x += bflo(d); s.y += bfhi(d); }
                    if (nlo > lo) { const unsigned d = *(const LAS unsigned*)(T + lo * 512 + 4 * cp); s.x -= bflo(d); s.y -= bfhi(d); }
                    lo = nlo; hi = nhi; }
                const float inv = fast_rcp((float)(hi - lo)); const unsigned ctr = *(const LAS unsigned*)(T + t * 512 + 4 * cp);
                *(LAS unsigned*)(P + t * 528 + 4 * cp) = pk2(s.x * inv - bflo(ctr), s.y * inv - bfhi(ctr));
            }
        }
        __syncthreads();
        f32x4 acc[4][2];
#pragma unroll
        for (int mt = 0; mt < 4; ++mt) { acc[mt][0] = (f32x4){0.f, 0.f, 0.f, 0.f}; acc[mt][1] = acc[mt][0]; }
#pragma unroll
        for (int kk = 0; kk < 8; ++kk)
#pragma unroll
            for (int mt = 0; mt < 4; ++mt) { const bf16x8 afr = *(const LAS bf16x8*)(P + (16 * mt + fr) * 528 + (32 * kk + 8 * fq) * 2);
                acc[mt][0] = mfma16(bfr[0][kk], afr, acc[mt][0]); acc[mt][1] = mfma16(bfr[1][kk], afr, acc[mt][1]); }
        const f32x4 sc0 = *(const f32x4*)(scale + colb), sc1 = *(const f32x4*)(scale + colb + 4);
#pragma unroll
        for (int mt = 0; mt < 4; ++mt) { const size_t o = (size_t)(br * 64 + 16 * mt + fr) * 1024 + colb;
            const f32x4 v0 = acc[mt][0] * sc0, v1 = acc[mt][1] * sc1;
            *(v4u*)(A4 + o) = (v4u){pk2(v0[0] * bflo(zz[mt][0]), v0[1] * bfhi(zz[mt][0])), pk2(v0[2] * bflo(zz[mt][1]), v0[3] * bfhi(zz[mt][1])),
                                     pk2(v1[0] * bflo(zz[mt][2]), v1[1] * bfhi(zz[mt][2])), pk2(v1[2] * bflo(zz[mt][3]), v1[3] * bfhi(zz[mt][3]))}; }
    }
    __syncthreads();
#undef POOL_LOAD
#undef POOL_UNIT
}

struct InProjOrder {
    pg8::StaticOrder lat;
    __device__ __forceinline__ bool next(int i, pg8::Unit& u) const {
        if (lat.next(i, u)) return true;
        const long t = (long)i * lat.G + lat.c - lat.nwg;
        if (t >= 96) return false;
        u.pm = 64 + (int)(t & 7); u.pn = (int)(t >> 3); return true;
    }
    __device__ __forceinline__ void a_ready(const pg8::Unit&) const {}
    __device__ __forceinline__ void done(const pg8::Unit&) const {}
};

__global__ void __launch_bounds__(512, 2) mega_fwd(Args a) {
    extern __shared__ __attribute__((aligned(16))) unsigned char lds_raw[];
    LAS unsigned char* lds = (LAS unsigned char*)lds_raw;
    const int lo = karg_i32(144), hi = karg_i32(148);
    const int wave_s = __builtin_amdgcn_readfirstlane(threadIdx.x >> 6);
#ifndef PROBE_MASK
#define PROBE_MASK 0
#endif
#define IN(k) (lo <= (k) && (k) < hi)
#define REP(k) for (int rep_ = 0; rep_ < (((PROBE_MASK) >> (k)) & 1) + 1; ++rep_, ((((PROBE_MASK) >> (k)) & 1) && rep_ == 1 ? xcd_barrier((unsigned*)(KA_WS() + WS_BAR), (volatile LAS unsigned*)(lds + LDS_ST_OFF), (wave_s == 0) && (__builtin_amdgcn_mbcnt_hi(~0u, __builtin_amdgcn_mbcnt_lo(~0u, 0u)) == 0u), gridDim.x) : (void)0))
#ifndef SYNC_REPS
#define SYNC_REPS 1
#endif
    volatile LAS unsigned* bar_st = (volatile LAS unsigned*)(lds + LDS_ST_OFF);
    const bool leader = (wave_s == 0) && (__builtin_amdgcn_mbcnt_hi(~0u, __builtin_amdgcn_mbcnt_lo(~0u, 0u)) == 0u);
    const bool grp_ok = (gridDim.x % 8u) == 0u;
    Grp gp; gp.ng = grp_ok ? 8 : 1; gp.g = grp_ok ? (int)(blockIdx.x & 7u) : 0; gp.lb = grp_ok ? (int)(blockIdx.x >> 3) : (int)blockIdx.x; gp.nblk = grp_ok ? (int)(gridDim.x >> 3) : (int)gridDim.x;
    if (leader) { bar_st[0] = 0u; bar_st[1] = 0u; bar_st[2] = 0u; bar_st[3] = 0u; const unsigned x = xb_xcc_id();
        (void)xb_add((unsigned*)(KA_WS() + WS_BAR) + XB_XCNT(x), 1u); (void)xb_add((unsigned*)(KA_WS() + WS_BAR) + (1 + gp.g) * XCD_BAR_WORDS + XB_XCNT(x), 1u); }
    __syncthreads();
    if (lo < -1000) cg::this_grid().sync();
#define SEAM(k) do { if (IN(k) && IN((k) + 1)) for (int sr_ = 0; sr_ < SYNC_REPS; ++sr_) xcd_barrier((unsigned*)(KA_WS() + WS_BAR), bar_st, leader, gridDim.x); } while (0)
#define SEAM_GRP(k) do { if (IN(k) && IN((k) + 1)) { if (grp_ok) xcd_barrier((unsigned*)(KA_WS() + WS_BAR) + (1 + gp.g) * XCD_BAR_WORDS, bar_st + 2, leader, (unsigned)gp.nblk); \
                                                      else xcd_barrier((unsigned*)(KA_WS() + WS_BAR), bar_st, leader, gridDim.x); } } while (0)
    unsigned char* ws = KA_WS();
    if (IN(0)) REP(0) { phase_prologue(a, lds, wave_s); } SEAM(0);
    if (IN(1)) REP(1) { phase_modnorm(a, 0, KA_IN(0), MT, (bf16*)KA_OUT(), wave_s, gp); } SEAM_GRP(1);
    if (IN(2)) REP(2) {
        EpiInProj E{ws, 0};
        pg8::Gemm g{(const bf16*)KA_OUT(), (const bf16*)(ws + WS_W0T), MT, 5120, 1024, 1024, 1024, 0}; InProjOrder S; S.lat.init(MT, 5120, gridDim.x, blockIdx.x);
        pg8::gemm_phase<EpiInProj, InProjOrder>(lds, g, S, E, wave_s);
        if (gridDim.x == 256 && blockIdx.x >= 96) phase_late_weights(lds, wave_s, ((int)blockIdx.x - 96) * 8 + wave_s, 160 * 8);
    } SEAM_GRP(2);
    if (IN(3)) REP(3) { phase_gla(a, lds, wave_s, gp); } SEAM_GRP(3);
    if (IN(4)) REP(4) { phase_headnorm(a, wave_s, gp); } SEAM(4);
    const bool fuse = (gridDim.x == 256);
    if (IN(5)) REP(5) {
        pg8::Gemm g{(const bf16*)(ws + WS_A1), (const bf16*)(ws + WS_W1T), MT, 1024, 1024, 1024, 1024, 0}; pg8::StaticOrder S; S.init(MT, 1024, gridDim.x, blockIdx.x);
        if (fuse) {
            EpiResidNorm<0> E{KA_IN(0), (void*)(ws + WS_X1), (const float*)(ws + WS_MOD) + 2048, KA_IN(6) + 1024, (const float*)(ws + WS_MOD) + 9 * 3072, (bf16*)(ws + WS_A2),
                              (float*)(ws + WS_PART), (unsigned*)(ws + WS_BAR) + BAR_CNT_WORD0, (unsigned*)(ws + WS_BAR)};
            pg8::gemm_phase<EpiResidNorm<0>, pg8::StaticOrder>(lds, g, S, E, wave_s);
        } else {
            EpiResid E{KA_IN(0), (float*)(ws + WS_X1), (const float*)(ws + WS_MOD) + 2048};
            pg8::gemm_phase<EpiResid, pg8::StaticOrder>(lds, g, S, E, wave_s);
        }
    } SEAM_GRP(5);
    if (IN(6) && !fuse) REP(6) { phase_modnorm(a, 1, (const float*)(ws + WS_X1), MT, (bf16*)(ws + WS_A2), wave_s, gp); }
    if (!fuse) SEAM(6);
    if (IN(7)) REP(7) {
        EpiPoolIn E{(bf16*)(ws + WS_U), (bf16*)(ws + WS_ZP)};
        pg8::Gemm g{(const bf16*)(ws + WS_A2), (const bf16*)(ws + WS_W2T), MT, 2048, 1024, 1024, 1024, 0}; pg8::StaticOrder S; S.init(MT, 2048, gridDim.x, blockIdx.x);
        pg8::gemm_phase<EpiPoolIn, pg8::StaticOrder>(lds, g, S, E, wave_s);
    } SEAM_GRP(7);
    if (IN(8)) REP(8) { phase_pool_grp(lds, wave_s, gp); } SEAM_GRP(8);
    if (IN(10)) REP(10) {
        pg8::Gemm g{(const bf16*)(ws + WS_A4), (const bf16*)(ws + WS_W3T), MT, 1024, 1024, 1024, 1024, 0}; pg8::StaticOrder S; S.init(MT, 1024, gridDim.x, blockIdx.x);
        if (fuse) {
            EpiResidNorm<1> E{(const void*)(ws + WS_X1), (void*)KA_OUT(), (const float*)(ws + WS_MOD) + 9 * 3072 + 2048, KA_IN(15), nullptr, nullptr,
                              (float*)(ws + WS_PART) + (size_t)MT * 16, (unsigned*)(ws + WS_BAR) + BAR_CNT_WORD0 + 4096, (unsigned*)(ws + WS_BAR)};
            pg8::gemm_phase<EpiResidNorm<1>, pg8::StaticOrder>(lds, g, S, E, wave_s);
        } else {
            EpiResid E{(const float*)(ws + WS_X1), KA_OUT(), (const float*)(ws + WS_MOD) + 9 * 3072 + 2048};
            pg8::gemm_phase<EpiResid, pg8::StaticOrder>(lds, g, S, E, wave_s);
        }
    }
    if (!fuse) { SEAM(10); if (IN(11)) REP(11) { phase_final(a, wave_s); } }
#undef IN
#undef SEAM
}

extern "C" void kernel_launch(void* const* d_in, const int* in_sizes, int n_in, void* d_out, int out_size, void* d_ws, size_t ws_size, hipStream_t stream) {
    static int grid = 0;
    if (grid == 0) {
        if (n_in != 16 || out_size != MT * D || ws_size < WS_END) { fprintf(stderr, "kernel_launch: unexpected shapes (n_in %d out %d ws %zu)\n", n_in, out_size, ws_size); grid = -1; return; }
        int dev = 0, cus = 0, per_cu = 0;
        (void)hipGetDevice(&dev); (void)hipDeviceGetAttribute(&cus, hipDeviceAttributeMultiprocessorCount, dev);
        if (hipFuncSetAttribute((const void*)mega_fwd, hipFuncAttributeMaxDynamicSharedMemorySize, LDS_BYTES) != hipSuccess) fprintf(stderr, "kernel_launch: hipFuncSetAttribute failed\n");
        if (hipOccupancyMaxActiveBlocksPerMultiprocessor(&per_cu, (const void*)mega_fwd, 512, LDS_BYTES) != hipSuccess || per_cu < 1) { fprintf(stderr, "kernel_launch: occupancy query gave %d\n", per_cu); per_cu = 1; }
        (void)hipGetLastError();
        grid = cus * per_cu;
        fprintf(stderr, "kernel_launch: grid %d (cus %d x %d)\n", grid, cus, per_cu);
    }
    if (grid < 0) return;
    Args a{};
    for (int i = 0; i < 16; ++i) a.in[i] = (const float*)d_in[i];
    a.out = (float*)d_out; a.ws = (unsigned char*)d_ws;
#if MK_N_LAUNCHES == 1
    if (hipMemsetAsync((char*)d_ws + WS_BAR, 0, BAR_BYTES, stream) != hipSuccess) fprintf(stderr, "kernel_launch: memset of barrier words failed\n");
    a.ph_lo = 0; a.ph_hi = NPHASE;
    void* args[] = {&a};
    hipError_t e = hipLaunchCooperativeKernel((const void*)mega_fwd, dim3(grid), dim3(512), args, LDS_BYTES, stream);
    if (e != hipSuccess) fprintf(stderr, "kernel_launch: cooperative launch failed: %s (grid %d)\n", hipGetErrorString(e), grid);
#else
    for (int ph = 0; ph < NPHASE; ++ph) { a.ph_lo = ph; a.ph_hi = ph + 1; hipLaunchKernelGGL(mega_fwd, dim3(grid), dim3(512), LDS_BYTES, stream, a); }
#endif
}
```

```cpp
#include <hip/hip_runtime.h>
#include <hip/hip_cooperative_groups.h>
#include <cstdio>
#include <cstdint>
namespace cg = cooperative_groups;
#ifndef MK_N_LAUNCHES
#define MK_N_LAUNCHES 1
#define PROBE_MASK 0
#endif
namespace pg8 {
#define PG8_LAS __attribute__((address_space(3)))
typedef unsigned short bf16_t;
typedef short bf16x8 __attribute__((ext_vector_type(8)));
typedef float f32x4 __attribute__((ext_vector_type(4)));
typedef unsigned u32x4 __attribute__((ext_vector_type(4)));
constexpr int BM = 256, BK = 64, HALF = 128, HTB = HALF * BK * 2  , STAGE_BYTES = 8 * HTB, NXCD = 8, WGM = 8;

__host__ __device__ __forceinline__ int lds_byte(int r, int c) { const int st = (r >> 4) * 2 + (c >> 5), rr = r & 15, cc = c & 31, ob = rr * 64 + cc * 2; return st * 1024 + (ob ^ (((ob >> 9) & 1) << 5)); }
__host__ __device__ __forceinline__ void stage_rc(int b, int& R, int& C) { const int st = b / 1024, sb = b % 1024, swz = sb ^ (((sb >> 9) & 1) << 5); R = (st >> 1) * 16 + swz / 64; C = (st & 1) * 32 + (swz % 64) / 2; }
__host__ __device__ __forceinline__ int perm32(int rho) { const int n = rho >> 4, i = rho & 15; return 8 * (i >> 2) + 4 * n + (i & 3); }

struct Unit { int pm, pn; };
struct Gemm { const bf16_t* A; const bf16_t* Bt; int M, N, K, lda, ldb, a_pn_bytes; };

struct StaticOrder {
    int nM, nN, nwg, G, c;
    __host__ __device__ void init(int M, int N, int G_, int c_) { nM = M / BM; nN = N / BM; nwg = nM * nN; G = G_; c = c_; }
    __host__ __device__ bool next(int i, Unit& u) const {
        const long L = (long)i * G + c; if (L >= nwg) return false;
        int wgid = (int)L; { const int q = nwg / NXCD, r = nwg % NXCD, xcd = wgid % NXCD, off = wgid / NXCD; wgid = (xcd < r ? xcd * (q + 1) : r * (q + 1) + (xcd - r) * q) + off; }
        const int nig = WGM * nN, gid = wgid / nig, fm = gid * WGM, gsz = (nM - fm) < WGM ? (nM - fm) : WGM;
        u.pm = fm + ((wgid % nig) % gsz); u.pn = (wgid % nig) / gsz; return true;
    }
    __device__ __forceinline__ void a_ready(const Unit&) const {}
    __device__ __forceinline__ void done(const Unit&) const {}
};

template <class Epi, class Sched>
__device__ __forceinline__ void gemm_phase(PG8_LAS unsigned char* lds, const Gemm g, const Sched& S, const Epi& E, const int wave_s) {
    int tid_ = wave_s * 64 + (int)__builtin_amdgcn_mbcnt_hi(~0u, __builtin_amdgcn_mbcnt_lo(~0u, 0u)); const int tid = tid_, wid = __builtin_amdgcn_readfirstlane(tid >> 6), lane = tid & 63, wr = wid >> 2, wc = wid & 3, fr = lane & 15, fq = lane >> 4;
    const int K = g.K, nt = K / BK;
    unsigned voffA[2], voffB[2];
#pragma unroll
    for (int i = 0; i < 2; ++i) { int R, C; stage_rc(tid * 16 + i * 8192, R, C); const int Rb = Epi::PERM ? ((R & ~31) + perm32(R & 31)) : R;
        voffA[i] = (unsigned)(R * g.lda + C) * 2u; voffB[i] = (unsigned)(Rb * g.ldb + C) * 2u; }
    const size_t kstep = (size_t)(BK * 2);
    const size_t hstepA = (size_t)HALF * g.lda * 2, hstepB = (size_t)HALF * g.ldb * 2;
    const size_t tstepA = 2 * hstepA, tstepB = 2 * hstepB;
    const unsigned ldsw = (unsigned)wid * 1024u;
    const int aoff = lds_byte(wr * 64 + fr, fq * 8), boff = lds_byte(wc * 32 + fr, fq * 8);
#define PG8_SA(b, h) (((b) * 2 + (h)) * HTB)
#define PG8_SB(b, h) ((4 + (b) * 2 + (h)) * HTB)
#define PG8_STAGE(bufoff, gbase, voff) do { _Pragma("unroll") for (int _i = 0; _i < 2; ++_i) \
        __builtin_amdgcn_global_load_lds((const unsigned*)((const char*)(gbase) + (voff)[_i]), (PG8_LAS unsigned*)(lds + (bufoff) + ldsw + _i * 8192), 16, 0, 0); } while (0)
#define PG8_LDA(dst, b, h) do { _Pragma("unroll") for (int m = 0; m < 4; ++m) _Pragma("unroll") for (int k = 0; k < 2; ++k) dst[m][k] = *(const PG8_LAS bf16x8*)(lds + PG8_SA(b, h) + aoff + m * 2048 + k * 1024); } while (0)
#define PG8_LDB(dst, b, h) do { _Pragma("unroll") for (int n = 0; n < 2; ++n) _Pragma("unroll") for (int k = 0; k < 2; ++k) dst[n][k] = *(const PG8_LAS bf16x8*)(lds + PG8_SB(b, h) + boff + n * 2048 + k * 1024); } while (0)
#define PG8_MMA(ai, bj, At, Bt) do { __builtin_amdgcn_s_setprio(1); _Pragma("unroll") for (int m = 0; m < 4; ++m) _Pragma("unroll") for (int n = 0; n < 2; ++n) _Pragma("unroll") for (int k = 0; k < 2; ++k) \
        acc[ai][bj][m][n] = __builtin_amdgcn_mfma_f32_16x16x32_bf16(Bt[n][k], At[m][k], acc[ai][bj][m][n], 0, 0, 0); __builtin_amdgcn_s_setprio(0); } while (0)
#define PG8_WAIT_V(n) asm volatile("s_waitcnt vmcnt(" #n ")" ::: "memory")
#define PG8_WAIT_L(n) asm volatile("s_waitcnt lgkmcnt(" #n ")" ::: "memory")
#define PG8_BAR __builtin_amdgcn_s_barrier()
#define PG8_SCHED __builtin_amdgcn_sched_barrier(0)
    Unit cur, nxt; int ui = 0;
    if (!S.next(0, cur)) return;
    f32x4 acc[2][2][4][2];
#pragma unroll
    for (int a = 0; a < 2; ++a)
#pragma unroll
        for (int b = 0; b < 2; ++b)
#pragma unroll
            for (int m = 0; m < 4; ++m)
#pragma unroll
                for (int n = 0; n < 2; ++n) acc[a][b][m][n] = (f32x4){0.f, 0.f, 0.f, 0.f};
    bf16x8 At[4][2], B0[2][2], B1[2][2];
    const char* cA = (const char*)g.A + (size_t)cur.pm * tstepA + (size_t)cur.pn * g.a_pn_bytes; const char* cB = (const char*)g.Bt + (size_t)cur.pn * tstepB;
    S.a_ready(cur);
    PG8_STAGE(PG8_SB(0, 0), cB, voffB); PG8_STAGE(PG8_SA(0, 0), cA, voffA); PG8_STAGE(PG8_SB(0, 1), cB + hstepB, voffB); PG8_STAGE(PG8_SA(0, 1), cA + hstepA, voffA);
    if (wr == 1) PG8_BAR;
    PG8_WAIT_V(4); PG8_BAR;
    PG8_STAGE(PG8_SB(1, 0), cB + kstep, voffB); PG8_STAGE(PG8_SA(1, 0), cA + kstep, voffA); PG8_STAGE(PG8_SB(1, 1), cB + hstepB + kstep, voffB);
    PG8_WAIT_V(6); PG8_BAR;
    for (;;) {
        const bool has_next = S.next(ui + 1, nxt);
        const char* nA = has_next ? (const char*)g.A + (size_t)nxt.pm * tstepA + (size_t)nxt.pn * g.a_pn_bytes : cA; const char* nB = has_next ? (const char*)g.Bt + (size_t)nxt.pn * tstepB : cB;
        for (int t = 0; t < nt; t += 2) {
            const bool last = (t == nt - 2);
            const char* a1 = cA + (size_t)(t + 1) * kstep;
            const char* a2 = last ? nA : cA + (size_t)(t + 2) * kstep; const char* b2 = last ? nB : cB + (size_t)(t + 2) * kstep;
            const char* a3 = a2 + kstep; const char* b3 = b2 + kstep;
            if (last && has_next) S.a_ready(nxt);
            PG8_LDB(B0, 0, 0); PG8_SCHED; PG8_LDA(At, 0, 0); PG8_STAGE(PG8_SA(1, 1), a1 + hstepA, voffA);
            PG8_WAIT_L(8); PG8_BAR; PG8_WAIT_L(0); PG8_MMA(0, 0, At, B0); PG8_BAR; PG8_SCHED;
            PG8_LDB(B1, 0, 1); PG8_STAGE(PG8_SB(0, 0), b2, voffB);
            PG8_BAR; PG8_WAIT_L(0); PG8_MMA(0, 1, At, B1); PG8_BAR;
            PG8_LDA(At, 0, 1); PG8_STAGE(PG8_SA(0, 0), a2, voffA);
            PG8_BAR; PG8_WAIT_L(0); PG8_MMA(1, 0, At, B0); PG8_BAR; PG8_SCHED;
            PG8_STAGE(PG8_SB(0, 1), b2 + hstepB, voffB);
            PG8_WAIT_V(6); PG8_BAR; PG8_MMA(1, 1, At, B1); PG8_BAR;
            PG8_LDB(B0, 1, 0); PG8_SCHED; PG8_LDA(At, 1, 0); PG8_STAGE(PG8_SA(0, 1), a2 + hstepA, voffA);
            PG8_WAIT_L(8); PG8_BAR; PG8_WAIT_L(0); PG8_MMA(0, 0, At, B0); PG8_BAR; PG8_SCHED;
            PG8_LDB(B1, 1, 1); PG8_STAGE(PG8_SB(1, 0), b3, voffB);
            PG8_BAR; PG8_WAIT_L(0); PG8_MMA(0, 1, At, B1); PG8_BAR;
            PG8_LDA(At, 1, 1); PG8_STAGE(PG8_SA(1, 0), a3, voffA);
            PG8_BAR; PG8_WAIT_L(0); PG8_MMA(1, 0, At, B0); PG8_BAR; PG8_SCHED;
            PG8_STAGE(PG8_SB(1, 1), b3 + hstepB, voffB);
            PG8_WAIT_V(6); PG8_BAR; PG8_MMA(1, 1, At, B1); PG8_BAR;
        }
        if constexpr (!Epi::AFTER_DRAIN) { E(acc, cur, wr, wc, fr, fq); S.done(cur); }
        if (!has_next) break;
#pragma unroll
        for (int a = 0; a < 2; ++a)
#pragma unroll
            for (int b = 0; b < 2; ++b)
#pragma unroll
                for (int m = 0; m < 4; ++m)
#pragma unroll
                    for (int n = 0; n < 2; ++n) acc[a][b][m][n] = (f32x4){0.f, 0.f, 0.f, 0.f};
        cur = nxt; cA = nA; cB = nB; ++ui;
    }
    PG8_WAIT_V(0);
    if (wr == 0) PG8_BAR;
    PG8_BAR;
    if constexpr (Epi::AFTER_DRAIN) { E.fused(acc, cur, wr, wc, fr, fq, lds, wid, lane); S.done(cur); }
#undef PG8_SA
#undef PG8_SB
#undef PG8_STAGE
#undef PG8_LDA
#undef PG8_LDB
#undef PG8_MMA
#undef PG8_WAIT_V
#undef PG8_WAIT_L
#undef PG8_BAR
#undef PG8_SCHED
}
}

constexpr int BATCH = 8, SEQ = 2048, D = 1024, CTX = 256;
constexpr int MT = BATCH * SEQ;
constexpr int MC = BATCH * CTX;
constexpr int MA = MT + MC;
constexpr float EPS = 1e-6f;
constexpr int NPHASE = 12;
constexpr size_t MiB = 1u << 20;
constexpr size_t WS_MOD = 0;
constexpr size_t WS_LB = 512 * 1024;
constexpr size_t WS_BAR = 768 * 1024;
constexpr size_t WS_W0T = 1 * MiB;
constexpr size_t WS_W1T = 11 * MiB;
constexpr size_t WS_W2T = 13 * MiB;
constexpr size_t WS_WGT = 17 * MiB;
constexpr size_t WS_W3T = 18 * MiB;
constexpr size_t WS_FF = 20 * MiB;
constexpr size_t WS_FB = 56 * MiB;
constexpr size_t WS_V = 92 * MiB;
constexpr size_t WS_Q = 128 * MiB;
constexpr size_t WS_Z = 160 * MiB;
constexpr size_t WS_OB = 192 * MiB;
constexpr size_t WS_A1 = 20 * MiB;
constexpr size_t WS_X1 = 64 * MiB;
constexpr size_t WS_A2 = 128 * MiB;
constexpr size_t WS_U = 192 * MiB;
constexpr size_t WS_ZP = 160 * MiB;
constexpr size_t WS_A3 = 20 * MiB;
constexpr size_t WS_A4 = 128 * MiB;
constexpr size_t WS_PART = 52 * MiB;
constexpr size_t WS_END = 256 * MiB;
constexpr int BAR_CNT_WORD0 = 32768;
constexpr int BAR_BYTES = (32768 + 2 * 4096) * 4;

constexpr int LDS_BYTES = 131072 + 64;
constexpr int LDS_ST_OFF = 131072;

#define LAS __attribute__((address_space(3)))
typedef unsigned short bf16;
typedef unsigned v4u __attribute__((ext_vector_type(4)));
typedef unsigned v2u __attribute__((ext_vector_type(2)));
typedef float f32x4 __attribute__((ext_vector_type(4)));
typedef float f32x2 __attribute__((ext_vector_type(2)));
typedef short bf16x8 __attribute__((ext_vector_type(8)));
#define LDS_WAIT() asm volatile("s_waitcnt lgkmcnt(0)" ::: "memory")

typedef __bf16 bf16x2_t __attribute__((ext_vector_type(2)));
__device__ __forceinline__ unsigned pk2(float lo, float hi) { const bf16x2_t r = __builtin_convertvector((f32x2){lo, hi}, bf16x2_t); return __builtin_bit_cast(unsigned, r); }
__device__ __forceinline__ float bflo(unsigned u) { return __builtin_bit_cast(float, u << 16); }
__device__ __forceinline__ float bfhi(unsigned u) { return __builtin_bit_cast(float, u & 0xffff0000u); }
__device__ __forceinline__ float fast_rcp(float x) { return __builtin_amdgcn_rcpf(x); }
__device__ __forceinline__ float sigmoidf_(float x) { return fast_rcp(1.f + __expf(-x)); }
__device__ __forceinline__ float siluf_(float x) { return x * sigmoidf_(x); }
__device__ __forceinline__ float wave_sum(float v) {
#pragma unroll
    for (int o = 1; o < 64; o <<= 1) v += __shfl_xor(v, o);
    return v;
}


#define XB_TMO      128
#define XB_XCNT(j)  (256  + 64 * (j))
#define XB_XSUB(j)  (1280 + 64 * (j))
#define XB_XGEN(j)  (2304 + 64 * (j))
#define XB_TOP      3328
#define XB_TOPGEN   3392
#define XCD_BAR_WORDS 3456
#define XB_SPIN_CAP (1u << 18)
__device__ __forceinline__ unsigned xb_ld(unsigned* p)              { return __hip_atomic_load(p, __ATOMIC_RELAXED, __HIP_MEMORY_SCOPE_AGENT); }
__device__ __forceinline__ unsigned xb_add(unsigned* p, unsigned v) { return __hip_atomic_fetch_add(p, v, __ATOMIC_RELAXED, __HIP_MEMORY_SCOPE_AGENT); }
__device__ __forceinline__ unsigned xb_xcc_id() { return (unsigned)__builtin_amdgcn_s_getreg((3 << 11) | 20) & 0xFu; }
#define XB_SPIN(cond, bar) do { unsigned _sp = 0; while (cond) { __builtin_amdgcn_s_sleep(1); \
    if ((++_sp & 255u) == 0u) { if (xb_ld(&(bar)[XB_TMO])) break; if (_sp > XB_SPIN_CAP) { atomicAdd(&(bar)[XB_TMO], 1u); break; } } } } while (0)
__device__ __forceinline__ void xcd_barrier_complete(unsigned* bar, unsigned x, unsigned& nloc, unsigned& nx, const unsigned G) {
    unsigned sum, cnt, mine, sp = 0u;
    for (;;) {
        sum = 0u; cnt = 0u; mine = 0u;
#pragma unroll
        for (unsigned j = 0; j < 16; ++j) { const unsigned c = xb_ld(&bar[XB_XCNT(j)]); sum += c; cnt += (c > 0u) ? 1u : 0u; mine = (j == x) ? c : mine; }
        if (sum == G) break;
        __builtin_amdgcn_s_sleep(1);
        if ((++sp & 255u) == 0u) { if (xb_ld(&bar[XB_TMO])) break; if (sp > XB_SPIN_CAP) { atomicAdd(&bar[XB_TMO], 1u); break; } }
    }
    nloc = mine > 0u ? mine : 1u; nx = cnt > 0u ? cnt : 1u;
}
__device__ __forceinline__ void xcd_barrier(unsigned* bar, volatile LAS unsigned* st, const bool leader, const unsigned G) {
    asm volatile("s_waitcnt vmcnt(0)" ::: "memory");
    __syncthreads();
    if (leader) {
        const unsigned x = xb_xcc_id();
        __builtin_amdgcn_s_waitcnt(0);
        unsigned nloc = st[0], nx = st[1];
        if (nloc == 0u) { xcd_barrier_complete(bar, x, nloc, nx, G); st[0] = nloc; st[1] = nx; }
        const unsigned old = xb_add(&bar[XB_XSUB(x)], 1u);
        const unsigned gen = old / nloc;
        if (old + 1u == (gen + 1u) * nloc) {
            __builtin_amdgcn_fence(__ATOMIC_RELEASE, "agent");
            asm volatile("s_waitcnt vmcnt(0)" ::: "memory");
            const unsigned og = xb_add(&bar[XB_TOP], 1u);
            const unsigned tg = og / nx;
            if (og + 1u == (tg + 1u) * nx) xb_add(&bar[XB_TOPGEN], 1u);
            else XB_SPIN(xb_ld(&bar[XB_TOPGEN]) == tg, bar);
            __builtin_amdgcn_fence(__ATOMIC_ACQUIRE, "agent");
            xb_add(&bar[XB_XGEN(x)], 1u);
            asm volatile("s_waitcnt vmcnt(0)" ::: "memory");
        } else {
            XB_SPIN(xb_ld(&bar[XB_XGEN(x)]) == gen, bar);
            __builtin_amdgcn_fence(__ATOMIC_ACQUIRE, "agent");
            asm volatile("s_waitcnt vmcnt(0)" ::: "memory");
        }
    }
    __syncthreads();
}

struct Grp { int g, lb, nblk, ng; };

struct Args { const float* in[16]; float* out; unsigned char* ws; int ph_lo, ph_hi; };
#define GAS __attribute__((address_space(1)))
#define CAS __attribute__((address_space(4)))
__device__ __forceinline__ const unsigned char CAS* karg_base() { const unsigned char CAS* p = (const unsigned char CAS*)__builtin_amdgcn_kernarg_segment_ptr(); asm volatile("" : "+s"(p)); return p; }
__device__ __forceinline__ unsigned long long karg_u64(int off) { return *(const unsigned long long CAS*)(karg_base() + off); }
__device__ __forceinline__ int karg_i32(int off) { return *(const int CAS*)(karg_base() + off); }
#define KA_IN(i) ((const float*)(const float GAS*)karg_u64(8 * (i)))
#define KA_OUT() ((float*)(float GAS*)karg_u64(128))
#define KA_WS() ((unsigned char*)(unsigned char GAS*)karg_u64(136))
static_assert(sizeof(Args) == 152, "Args layout");

struct EpiInProj {
    static constexpr bool PERM = true, AFTER_DRAIN = false;
    unsigned char* ws; int row_off;
    __device__ __forceinline__ void operator()(const f32x4 (&acc)[2][2][4][2], const pg8::Unit& u, int wr, int wc, int fr, int fq) const {
        const int type = u.pn >> 2, colt = (u.pn & 3) * 256;
        const int row0 = row_off + u.pm * 256 + wr * 64 + fr, col0 = colt + wc * 32 + 8 * fq;
        if (type < 2) {
            bf16* F = (bf16*)(ws + (type == 0 ? WS_FF : WS_FB)); const float* lbp = (const float*)(ws + WS_LB) + type * 1024 + col0;
            f32x4 lv[2][2];
#pragma unroll
            for (int bj = 0; bj < 2; ++bj)
#pragma unroll
                for (int n = 0; n < 2; ++n) lv[bj][n] = *(const f32x4*)(lbp + bj * 128 + 4 * n);
#pragma unroll
            for (int ai = 0; ai < 2; ++ai)
#pragma unroll
                for (int m = 0; m < 4; ++m) { bf16* rowp = F + (size_t)(row0 + ai * 128 + m * 16) * 1024 + col0;
#pragma unroll
                    for (int bj = 0; bj < 2; ++bj) { unsigned o[4];
#pragma unroll
                        for (int n = 0; n < 2; ++n) { float q[4];
#pragma unroll
                            for (int e = 0; e < 4; ++e) { const float l = lv[bj][n][e]; const float f = l + (1.f - l) * sigmoidf_(acc[ai][bj][m][n][e]);
                                q[e] = __builtin_rintf(f * 65535.f); }
                            o[2 * n] = (unsigned)q[0] | ((unsigned)q[1] << 16); o[2 * n + 1] = (unsigned)q[2] | ((unsigned)q[3] << 16); }
                        *(v4u*)(rowp + bj * 128) = (v4u){o[0], o[1], o[2], o[3]}; } }
        } else {
            bf16* O = (bf16*)(ws + (type == 2 ? WS_V : (type == 3 ? WS_Q : WS_Z)));
            const float qs = type == 3 ? 0.08838834764831845f : 1.f;
#pragma unroll
            for (int ai = 0; ai < 2; ++ai)
#pragma unroll
                for (int m = 0; m < 4; ++m) { bf16* rowp = O + (size_t)(row0 + ai * 128 + m * 16) * 1024 + col0;
#pragma unroll
                    for (int bj = 0; bj < 2; ++bj) { f32x4 v0 = acc[ai][bj][m][0], v1 = acc[ai][bj][m][1];
                        if (type >= 3) {
#pragma unroll
                            for (int e = 0; e < 4; ++e) { v0[e] = siluf_(v0[e]) * qs; v1[e] = siluf_(v1[e]) * qs; } }
                        *(v4u*)(rowp + bj * 128) = (v4u){pk2(v0[0], v0[1]), pk2(v0[2], v0[3]), pk2(v1[0], v1[1]), pk2(v1[2], v1[3])}; } }
        }
    }
};
struct EpiResid {
    static constexpr bool PERM = false, AFTER_DRAIN = false;
    const float* xin; float* out; const float* gate;
    __device__ __forceinline__ void operator()(const f32x4 (&acc)[2][2][4][2], const pg8::Unit& u, int wr, int wc, int fr, int fq) const {
        const int row0 = u.pm * 256 + wr * 64 + fr, col0 = u.pn * 256 + wc * 32 + 4 * fq;
        const float* gp = gate + (size_t)(u.pm >> 3) * 3072 + col0;
        f32x4 gv[2][2];
#pragma unroll
        for (int bj = 0; bj < 2; ++bj)
#pragma unroll
            for (int n = 0; n < 2; ++n) gv[bj][n] = *(const f32x4*)(gp + bj * 128 + n * 16);
#pragma unroll
        for (int ai = 0; ai < 2; ++ai)
#pragma unroll
            for (int m = 0; m < 4; ++m) { const size_t ro = (size_t)(row0 + ai * 128 + m * 16) * 1024 + col0;
#pragma unroll
                for (int bj = 0; bj < 2; ++bj)
#pragma unroll
                    for (int n = 0; n < 2; ++n) { const f32x4 xv = *(const f32x4*)(xin + ro + bj * 128 + n * 16);
                        *(f32x4*)(out + ro + bj * 128 + n * 16) = xv + gv[bj][n] * acc[ai][bj][m][n]; } }
    }
};

template <int MODE> struct EpiResidNorm {
    static constexpr bool PERM = true, AFTER_DRAIN = true;
    const void* xin; void* xout; const float* gate; const float* nw; const float* mod; bf16* A2; float* part; unsigned* cnt; unsigned* bar;
    __device__ __forceinline__ void operator()(const f32x4 (&)[2][2][4][2], const pg8::Unit&, int, int, int, int) const {}
    __device__ __forceinline__ void fused(f32x4 (&acc)[2][2][4][2], const pg8::Unit& u, int wr, int wc, int fr, int fq, LAS unsigned char*, int wid, int lane) const {
        const int row0 = u.pm * 256 + wr * 64 + fr, col0 = u.pn * 256 + wc * 32 + 8 * fq;
        const float* gp = gate + (size_t)(u.pm >> 3) * 3072 + col0;
        float ss[2][4];
        f32x4 gv[2][2];
#pragma unroll
        for (int bj = 0; bj < 2; ++bj)
#pragma unroll
            for (int n = 0; n < 2; ++n) gv[bj][n] = *(const f32x4*)(gp + bj * 128 + 4 * n);
#pragma unroll
        for (int ai = 0; ai < 2; ++ai) {
            v4u xb[4][2]; f32x4 xf[4][2][2];
#pragma unroll
            for (int m = 0; m < 4; ++m)
#pragma unroll
                for (int bj = 0; bj < 2; ++bj) { const size_t ro = (size_t)(row0 + ai * 128 + m * 16) * 1024 + col0 + bj * 128;
                    if (MODE == 0) { xf[m][bj][0] = *(const f32x4*)((const float*)xin + ro); xf[m][bj][1] = *(const f32x4*)((const float*)xin + ro + 4); }
                    else xb[m][bj] = *(const v4u*)((const bf16*)xin + ro); }
#pragma unroll
            for (int m = 0; m < 4; ++m) { float s = 0.f;
#pragma unroll
                for (int bj = 0; bj < 2; ++bj) { f32x4 xv[2];
                    if (MODE == 0) { xv[0] = xf[m][bj][0]; xv[1] = xf[m][bj][1]; }
                    else { const v4u q = xb[m][bj]; xv[0] = (f32x4){bflo(q[0]), bfhi(q[0]), bflo(q[1]), bfhi(q[1])}; xv[1] = (f32x4){bflo(q[2]), bfhi(q[2]), bflo(q[3]), bfhi(q[3])}; }
#pragma unroll
                    for (int n = 0; n < 2; ++n) { const f32x4 v = xv[n] + gv[bj][n] * acc[ai][bj][m][n]; acc[ai][bj][m][n] = v; s += (v.x * v.x + v.y * v.y) + (v.z * v.z + v.w * v.w); } }
                s += __shfl_xor(s, 16); s += __shfl_xor(s, 32); ss[ai][m] = s; } }
        if (fq == 0) {
#pragma unroll
            for (int ai = 0; ai < 2; ++ai)
#pragma unroll
                for (int m = 0; m < 4; ++m) __hip_atomic_store((unsigned*)(part + (size_t)(row0 + ai * 128 + m * 16) * 16 + u.pn * 4 + wc), __builtin_bit_cast(unsigned, ss[ai][m]), __ATOMIC_RELAXED, __HIP_MEMORY_SCOPE_AGENT); }
        asm volatile("s_waitcnt vmcnt(0)" ::: "memory");
        __syncthreads();
        if (wid == 0 && lane == 0) (void)xb_add(cnt + 64 * u.pm, 1u);
        if (MODE == 0) {
#pragma unroll
            for (int ai = 0; ai < 2; ++ai)
#pragma unroll
                for (int m = 0; m < 4; ++m)
#pragma unroll
                    for (int bj = 0; bj < 2; ++bj) { const f32x4 v0 = acc[ai][bj][m][0], v1 = acc[ai][bj][m][1];
                        *(v4u*)((bf16*)xout + (size_t)(row0 + ai * 128 + m * 16) * 1024 + col0 + bj * 128) = (v4u){pk2(v0[0], v0[1]), pk2(v0[2], v0[3]), pk2(v1[0], v1[1]), pk2(v1[2], v1[3])}; } }
        if (wid == 0 && lane == 0) { unsigned* cw = cnt + 64 * u.pm; XB_SPIN(xb_ld(cw) < 4u, bar);
            __builtin_amdgcn_fence(__ATOMIC_ACQUIRE, "agent"); asm volatile("s_waitcnt vmcnt(0)" ::: "memory"); }
        __syncthreads();
        float rstd[2][4];
#pragma unroll
        for (int ai = 0; ai < 2; ++ai)
#pragma unroll
            for (int m = 0; m < 4; ++m) { unsigned* pp = (unsigned*)(part + (size_t)(row0 + ai * 128 + m * 16) * 16 + 4 * fq); float s = 0.f;
#pragma unroll
                for (int e = 0; e < 4; ++e) s += __builtin_bit_cast(float, __hip_atomic_load(pp + e, __ATOMIC_RELAXED, __HIP_MEMORY_SCOPE_AGENT));
                s += __shfl_xor(s, 16); s += __shfl_xor(s, 32);
                rstd[ai][m] = __builtin_amdgcn_rsqf(s * (1.f / 1024.f) + EPS); }
        if (MODE == 1) {
#pragma unroll
            for (int bj = 0; bj < 2; ++bj)
#pragma unroll
                for (int n = 0; n < 2; ++n) { const f32x4 w4 = *(const f32x4*)(nw + col0 + bj * 128 + 4 * n);
#pragma unroll
                    for (int ai = 0; ai < 2; ++ai)
#pragma unroll
                        for (int m = 0; m < 4; ++m) *(f32x4*)((float*)xout + (size_t)(row0 + ai * 128 + m * 16) * 1024 + col0 + bj * 128 + 4 * n) = acc[ai][bj][m][n] * rstd[ai][m] * w4; }
        } else {
            const float* mp = mod + (size_t)(u.pm >> 3) * 3072 + col0;
#pragma unroll
            for (int bj = 0; bj < 2; ++bj) { f32x4 g[2], sh[2];
#pragma unroll
                for (int n = 0; n < 2; ++n) { g[n] = *(const f32x4*)(nw + col0 + bj * 128 + 4 * n) * (*(const f32x4*)(mp + 1024 + bj * 128 + 4 * n) + 1.f); sh[n] = *(const f32x4*)(mp + bj * 128 + 4 * n); }
#pragma unroll
                for (int ai = 0; ai < 2; ++ai)
#pragma unroll
                    for (int m = 0; m < 4; ++m) { const f32x4 y0 = acc[ai][bj][m][0] * rstd[ai][m] * g[0] + sh[0], y1 = acc[ai][bj][m][1] * rstd[ai][m] * g[1] + sh[1];
                        *(v4u*)(A2 + (size_t)(row0 + ai * 128 + m * 16) * 1024 + col0 + bj * 128) = (v4u){pk2(y0[0], y0[1]), pk2(y0[2], y0[3]), pk2(y1[0], y1[1]), pk2(y1[2], y1[3])}; } }
        }
    }
};
struct EpiPoolIn {
    static constexpr bool PERM = true, AFTER_DRAIN = false;
    bf16* U; bf16* ZP;
    __device__ __forceinline__ void operator()(const f32x4 (&acc)[2][2][4][2], const pg8::Unit& u, int wr, int wc, int fr, int fq) const {
        const int type = u.pn >> 2, colt = (u.pn & 3) * 256;
        const int row0 = u.pm * 256 + wr * 64 + fr, col0 = colt + wc * 32 + 8 * fq;
#pragma unroll
        for (int ai = 0; ai < 2; ++ai)
#pragma unroll
            for (int m = 0; m < 4; ++m) { const size_t ro = (size_t)(row0 + ai * 128 + m * 16) * 1024 + col0;
#pragma unroll
                for (int bj = 0; bj < 2; ++bj) { f32x4 v0 = acc[ai][bj][m][0], v1 = acc[ai][bj][m][1];
                    if (type == 0) { *(v4u*)(U + ro + bj * 128) = (v4u){pk2(v0[0], v0[1]), pk2(v0[2], v0[3]), pk2(v1[0], v1[1]), pk2(v1[2], v1[3])}; }
                    else {
#pragma unroll
                        for (int e = 0; e < 4; ++e) { v0[e] = siluf_(v0[e]); v1[e] = siluf_(v1[e]); }
                        *(v4u*)(ZP + ro + bj * 128) = (v4u){pk2(v0[0], v0[1]), pk2(v0[2], v0[3]), pk2(v1[0], v1[1]), pk2(v1[2], v1[3])}; } } }
    }
};
struct EpiGrp {
    static constexpr bool PERM = true, AFTER_DRAIN = false;
    bf16* A4; const float* scale; const bf16* ZP;
    __device__ __forceinline__ void operator()(const f32x4 (&acc)[2][2][4][2], const pg8::Unit& u, int wr, int wc, int fr, int fq) const {
        const int row0 = u.pm * 256 + wr * 64 + fr, col0 = u.pn * 256 + wc * 32 + 8 * fq;
#pragma unroll
        for (int ai = 0; ai < 2; ++ai)
#pragma unroll
            for (int m = 0; m < 4; ++m) { const size_t ro = (size_t)(row0 + ai * 128 + m * 16) * 1024 + col0;
#pragma unroll
                for (int bj = 0; bj < 2; ++bj) { const v4u zz = *(const v4u*)(ZP + ro + bj * 128);
                    const f32x4 v0 = acc[ai][bj][m][0] * *(const f32x4*)(scale + col0 + bj * 128), v1 = acc[ai][bj][m][1] * *(const f32x4*)(scale + col0 + bj * 128 + 4);
                    *(v4u*)(A4 + ro + bj * 128) = (v4u){pk2(v0[0] * bflo(zz[0]), v0[1] * bfhi(zz[0])), pk2(v0[2] * bflo(zz[1]), v0[3] * bfhi(zz[1])),
                                                         pk2(v1[0] * bflo(zz[2]), v1[1] * bfhi(zz[2])), pk2(v1[2] * bflo(zz[3]), v1[3] * bfhi(zz[3]))}; } }
    }
};
__device__ __forceinline__ void transpose_item(const float* W, int K, int N, bf16* WT, int row_off, LAS float* scr, int item, int lane) {
    const int nblk = N / 32, kb = item / nblk, nb = item % nblk, k0 = 64 * kb, n0 = 32 * nb;
    float wv[32];
#pragma unroll
    for (int i = 0; i < 32; ++i) wv[i] = W[(size_t)(k0 + 2 * i + (lane >> 5)) * N + n0 + (lane & 31)];
#pragma unroll
    for (int i = 0; i < 32; ++i) scr[(2 * i + (lane >> 5)) * 33 + (lane & 31)] = wv[i];
    LDS_WAIT(); asm volatile("" ::: "memory");
    const int c = lane & 7;
#pragma unroll
    for (int j = 0; j < 4; ++j) { const int n = (lane >> 3) + 8 * j; const LAS float* s = scr + (8 * c) * 33 + n;
        v4u o; o.x = pk2(s[0 * 33], s[1 * 33]); o.y = pk2(s[2 * 33], s[3 * 33]); o.z = pk2(s[4 * 33], s[5 * 33]); o.w = pk2(s[6 * 33], s[7 * 33]);
        *(v4u*)(WT + (size_t)(row_off + n0 + n) * K + k0 + 8 * c) = o; }
    LDS_WAIT(); asm volatile("" ::: "memory");
}

__device__ __forceinline__ void phase_late_weights(LAS unsigned char* lds, const int wave_s, const int gw, const int NGW) {
    const int lane = (int)__builtin_amdgcn_mbcnt_hi(~0u, __builtin_amdgcn_mbcnt_lo(~0u, 0u));
    LAS float* scr = (LAS float*)(lds + wave_s * 8448);
    constexpr int I1 = 16 * 32, I2 = 16 * 64, IG = 4 * 8, I3 = 16 * 32;
    constexpr int NIT = I1 + I2 + 4 * IG + I3;
    for (int it = gw; it < NIT; it += NGW) {
        int r = it;
        if (r < I1) { transpose_item(KA_IN(10), 1024, 1024, (bf16*)(KA_WS() + WS_W1T), 0, scr, r, lane); continue; } r -= I1;
        if (r < I2) { transpose_item(KA_IN(11), 1024, 2048, (bf16*)(KA_WS() + WS_W2T), 0, scr, r, lane); continue; } r -= I2;
        if (r < 4 * IG) { const int g = r / IG; transpose_item(KA_IN(12) + (size_t)g * 65536, 256, 256, (bf16*)(KA_WS() + WS_WGT), g * 256, scr, r % IG, lane); continue; } r -= 4 * IG;
        transpose_item(KA_IN(14), 1024, 1024, (bf16*)(KA_WS() + WS_W3T), 0, scr, r, lane);
    }
}

__device__ __forceinline__ void phase_prologue(const Args& a, LAS unsigned char* lds, const int wave_s) {
    int tid_ = wave_s * 64 + (int)__builtin_amdgcn_mbcnt_hi(~0u, __builtin_amdgcn_mbcnt_lo(~0u, 0u)); const int tid = tid_, lane = tid & 63, wave = __builtin_amdgcn_readfirstlane(tid >> 6);
    const float* c = KA_IN(1); const float* cctx = KA_IN(3); const float* ada_w = KA_IN(4); const float* ada_b = KA_IN(5);
    float* MOD = (float*)(KA_WS() + WS_MOD);
    LAS float* sil = (LAS float*)(lds + 69632);
    LAS float* red = sil + 9 * 1024;
    bool have_sil = false;
    for (int task = blockIdx.x; task < 192; task += gridDim.x) {
        if (!have_sil) {
            for (int i = tid; i < 9 * 1024; i += 512) { const float v = i < 8192 ? c[i] : cctx[i - 8192]; sil[i] = siluf_(v); }
            have_sil = true;
        }
        __syncthreads();
        const int l = task / 96, n0 = (task % 96) * 32;
        const float* W = ada_w + (size_t)l * 1024 * 3072 + n0 + (lane & 31);
        float acc[9];
#pragma unroll
        for (int r = 0; r < 9; ++r) acc[r] = 0.f;
        const int kb = wave * 128 + (lane >> 5);
#pragma unroll
        for (int i0 = 0; i0 < 64; i0 += 32) { float wv[32];
#pragma unroll
            for (int i = 0; i < 32; ++i) wv[i] = W[(size_t)(kb + 2 * (i0 + i)) * 3072];
#pragma unroll
            for (int i = 0; i < 32; ++i) { const int k = kb + 2 * (i0 + i);
#pragma unroll
                for (int r = 0; r < 9; ++r) acc[r] += sil[r * 1024 + k] * wv[i]; } }
#pragma unroll
        for (int r = 0; r < 9; ++r) acc[r] += __shfl_xor(acc[r], 32);
        if (lane < 32) {
#pragma unroll
            for (int r = 0; r < 9; ++r) red[(wave * 9 + r) * 32 + lane] = acc[r]; }
        __syncthreads();
        if (tid < 288) { const int r = tid >> 5, n = tid & 31; float s = 0.f;
#pragma unroll
            for (int w = 0; w < 8; ++w) s += red[(w * 9 + r) * 32 + n];
            MOD[(size_t)(l * 9 + r) * 3072 + n0 + n] = s + ada_b[l * 3072 + n0 + n]; }
    }
    if (blockIdx.x == gridDim.x - 1) { const float* lg = KA_IN(8); float* LB = (float*)(KA_WS() + WS_LB);
        for (int i = tid; i < 2048; i += 512) LB[i] = sigmoidf_(lg[i]); }
    LAS float* scr = (LAS float*)(lds + wave * 8448);
    const int gw = blockIdx.x * 8 + wave, NGW = gridDim.x * 8;
    constexpr int I0 = 16 * 160;
    for (int it = gw; it < I0; it += NGW) transpose_item(KA_IN(7), 1024, 5120, (bf16*)(KA_WS() + WS_W0T), 0, scr, it, lane);
    phase_late_weights(lds, wave_s, gw, NGW);
}

template <int R> __device__ __forceinline__ void modnorm_rows(const float* xrow0, const float* nw, const float* mod, bf16* orow0, int lane) {
    f32x4 v[R][4]; float rstd[R];
#pragma unroll
    for (int r = 0; r < R; ++r)
#pragma unroll
        for (int j = 0; j < 4; ++j) v[r][j] = ((const f32x4*)(xrow0 + (size_t)r * 1024))[lane + 64 * j];
#pragma unroll
    for (int r = 0; r < R; ++r) { float s = 0.f;
#pragma unroll
        for (int j = 0; j < 4; ++j) s += (v[r][j].x * v[r][j].x + v[r][j].y * v[r][j].y) + (v[r][j].z * v[r][j].z + v[r][j].w * v[r][j].w);
        rstd[r] = __builtin_amdgcn_rsqf(wave_sum(s) * (1.f / 1024.f) + EPS); }
#pragma unroll
    for (int j = 0; j < 4; ++j) { const f32x4 w4 = ((const f32x4*)nw)[lane + 64 * j], sh = ((const f32x4*)mod)[lane + 64 * j], sc = ((const f32x4*)(mod + 1024))[lane + 64 * j];
        const f32x4 g = w4 * (sc + 1.f);
#pragma unroll
        for (int r = 0; r < R; ++r) { const f32x4 y = v[r][j] * rstd[r] * g + sh;
            ((unsigned long long*)(orow0 + (size_t)r * 1024))[lane + 64 * j] = (unsigned long long)pk2(y.x, y.y) | ((unsigned long long)pk2(y.z, y.w) << 32); } }
}
__device__ __forceinline__ void phase_modnorm(const Args& a, int layer, const float* xsrc, int nrows_x, bf16* dst, const int wave_s, const Grp gp) {
    const int lane = (int)__builtin_amdgcn_mbcnt_hi(~0u, __builtin_amdgcn_mbcnt_lo(~0u, 0u)), wave = wave_s;
    const int gw = gp.lb * 8 + wave, NGW = gp.nblk * 8;
    const float* MOD = (const float*)(KA_WS() + WS_MOD) + (size_t)layer * 9 * 3072;
    const float* nw = KA_IN(6) + layer * 1024;
    for (int b = gp.g; b < BATCH; b += gp.ng) {
        for (int r = gw * 4; r < SEQ; r += NGW * 4) { const int m = b * SEQ + r; modnorm_rows<4>(xsrc + (size_t)m * 1024, nw, MOD + (size_t)b * 3072, dst + (size_t)m * 1024, lane); }
        if (layer == 0) { const float* cx = KA_IN(2);
            for (int r = gw; r < CTX; r += NGW) { const int m = b * CTX + r; modnorm_rows<1>(cx + (size_t)m * 1024, nw, MOD + (size_t)8 * 3072, dst + (size_t)(MT + m) * 1024, lane); } }
    }
}
__device__ __forceinline__ void phase_headnorm(const Args& a, const int wave_s, const Grp gp) {
    const int lane = (int)__builtin_amdgcn_mbcnt_hi(~0u, __builtin_amdgcn_mbcnt_lo(~0u, 0u)), wave = wave_s;
    const int gw = gp.lb * 8 + wave, NGW = gp.nblk * 8;
    const bf16* OF = (const bf16*)KA_OUT(); const bf16* OB = (const bf16*)(KA_WS() + WS_OB); const bf16* Z = (const bf16*)(KA_WS() + WS_Z); bf16* A1 = (bf16*)(KA_WS() + WS_A1);
    const float* gwt = KA_IN(9);
    constexpr int R = 4;
    for (int b = gp.g; b < BATCH; b += gp.ng)
    for (int rr = gw * R; rr < SEQ; rr += NGW * R) { const int m = b * SEQ + rr;
        v4u of[R][2], ob[R][2], zz[R][2];
#pragma unroll
        for (int r = 0; r < R; ++r)
#pragma unroll
            for (int j = 0; j < 2; ++j) { const size_t o = (size_t)(m + r) * 1024 + 512 * j + 8 * lane;
                of[r][j] = *(const v4u*)(OF + o); ob[r][j] = *(const v4u*)(OB + o); zz[r][j] = *(const v4u*)(Z + o); }
#pragma unroll
        for (int j = 0; j < 2; ++j) { const f32x4 w0 = *(const f32x4*)(gwt + 512 * j + 8 * lane), w1 = *(const f32x4*)(gwt + 512 * j + 8 * lane + 4);
#pragma unroll
            for (int r = 0; r < R; ++r) { float o[8]; float s = 0.f;
#pragma unroll
                for (int e = 0; e < 4; ++e) { o[2 * e] = bflo(of[r][j][e]) + bflo(ob[r][j][e]); o[2 * e + 1] = bfhi(of[r][j][e]) + bfhi(ob[r][j][e]); s += o[2 * e] * o[2 * e] + o[2 * e + 1] * o[2 * e + 1]; }
#pragma unroll
                for (int sh = 1; sh < 16; sh <<= 1) s += __shfl_xor(s, sh);
                const float rstd = __builtin_amdgcn_rsqf(s * (1.f / 128.f) + EPS);
                v4u out;
#pragma unroll
                for (int e = 0; e < 4; ++e) { const float wa = e < 2 ? w0[2 * e] : w1[2 * e - 4], wb = e < 2 ? w0[2 * e + 1] : w1[2 * e - 3];
                    out[e] = pk2(o[2 * e] * rstd * wa * bflo(zz[r][j][e]), o[2 * e + 1] * rstd * wb * bfhi(zz[r][j][e])); }
                *(v4u*)(A1 + (size_t)(m + r) * 1024 + 512 * j + 8 * lane) = out; } }
    }
}
__device__ __forceinline__ void phase_pool(const Args& a, LAS unsigned char* lds, const int wave_s) {
    int tid_ = wave_s * 64 + (int)__builtin_amdgcn_mbcnt_hi(~0u, __builtin_amdgcn_mbcnt_lo(~0u, 0u)); const int tid = tid_;
    const bf16* Ub = (const bf16*)(KA_WS() + WS_U); bf16* A3 = (bf16*)(KA_WS() + WS_A3);
    v4u pre[4];
    int unit = blockIdx.x, buf = 0;
#define POOL_LOAD(un) do { const bf16* U_ = Ub + (size_t)((un) >> 2) * 64 * 1024 + ((un) & 3) * 256; \
        _Pragma("unroll") for (int i = 0; i < 4; ++i) { const int idx = tid + 512 * i; pre[i] = *(const v4u*)(U_ + (size_t)(idx >> 5) * 1024 + 8 * (idx & 31)); } } while (0)
    if (unit < 1024) POOL_LOAD(unit);
    for (; unit < 1024; unit += gridDim.x, buf ^= 1) {
        LAS float* T = (LAS float*)(lds + buf * 65536);
#pragma unroll
        for (int i = 0; i < 4; ++i) { const int idx = tid + 512 * i; LAS float* tp = T + (idx >> 5) * 256 + 8 * (idx & 31);
            *(LAS f32x4*)tp = (f32x4){bflo(pre[i][0]), bfhi(pre[i][0]), bflo(pre[i][1]), bfhi(pre[i][1])};
            *(LAS f32x4*)(tp + 4) = (f32x4){bflo(pre[i][2]), bfhi(pre[i][2]), bflo(pre[i][3]), bfhi(pre[i][3])}; }
        __syncthreads();
        if (unit + (int)gridDim.x < 1024) POOL_LOAD(unit + gridDim.x);
        const int g = unit & 3, br = unit >> 2;
        const int c = 2 * (tid & 127), t0 = (tid >> 7) * 16, hw = 1 << g;
        int lo = max(t0 - hw, 0), hi = min(t0 + hw, 64); f32x2 s = (f32x2){0.f, 0.f};
        for (int j = lo; j < hi; ++j) s += *(const LAS f32x2*)(T + j * 256 + c);
        bf16* op = A3 + (size_t)(br * 64) * 1024 + g * 256 + c;
#pragma unroll 4
        for (int t = t0; t < t0 + 16; ++t) {
            if (t > t0) { const int nlo = max(t - hw, 0), nhi = min(t + hw, 64);
                if (nhi > hi) s += *(const LAS f32x2*)(T + (nhi - 1) * 256 + c);
                if (nlo > lo) s -= *(const LAS f32x2*)(T + lo * 256 + c);
                lo = nlo; hi = nhi; }
            const float inv = fast_rcp((float)(hi - lo)); const f32x2 ctr = *(const LAS f32x2*)(T + t * 256 + c);
            *(unsigned*)(op + (size_t)t * 1024) = pk2(s.x * inv - ctr.x, s.y * inv - ctr.y);
        }
    }
    __syncthreads();
#undef POOL_LOAD
}
__device__ __forceinline__ void phase_final(const Args& a, const int wave_s) {
    int tid_ = wave_s * 64 + (int)__builtin_amdgcn_mbcnt_hi(~0u, __builtin_amdgcn_mbcnt_lo(~0u, 0u)); const int lane = tid_ & 63, wave = tid_ >> 6;
    const int gw = blockIdx.x * 8 + wave, NGW = gridDim.x * 8;
    const float* fw = KA_IN(15); float* out = KA_OUT();
    constexpr int R = 4;
    for (int m = gw * R; m < MT; m += NGW * R) {
        f32x4 v[R][4]; float rstd[R];
#pragma unroll
        for (int r = 0; r < R; ++r)
#pragma unroll
            for (int j = 0; j < 4; ++j) v[r][j] = ((const f32x4*)(out + (size_t)(m + r) * 1024))[lane + 64 * j];
#pragma unroll
        for (int r = 0; r < R; ++r) { float s = 0.f;
#pragma unroll
            for (int j = 0; j < 4; ++j) s += (v[r][j].x * v[r][j].x + v[r][j].y * v[r][j].y) + (v[r][j].z * v[r][j].z + v[r][j].w * v[r][j].w);
            rstd[r] = __builtin_amdgcn_rsqf(wave_sum(s) * (1.f / 1024.f) + EPS); }
#pragma unroll
        for (int j = 0; j < 4; ++j) { const f32x4 w4 = ((const f32x4*)fw)[lane + 64 * j];
#pragma unroll
            for (int r = 0; r < R; ++r) ((f32x4*)(out + (size_t)(m + r) * 1024))[lane + 64 * j] = v[r][j] * rstd[r] * w4; }
    }
}
constexpr int QS_OFF = 0, KS_OFF = 17408, KST_OFF = 34816, VT_OFF = 53248, SPT_OFF = 62464, TOT_OFF = 79872;
__device__ __forceinline__ f32x4 mfma16(bf16x8 a, bf16x8 b, f32x4 c) { return __builtin_amdgcn_mfma_f32_16x16x32_bf16(a, b, c, 0, 0, 0); }
__device__ __forceinline__ bf16x8 as_bf16x8(v4u v) { return __builtin_bit_cast(bf16x8, v); }

struct GlaRegs { unsigned f[8], q[8], v[8]; };
struct GlaCtx { const bf16* Fq; const bf16* Qb; const bf16* Vb; bf16* O; int b, h, dir, vs, w, lane, fr, fq; };
__device__ __forceinline__ int gla_rowbase(const GlaCtx& c, int i) { return i < 4 ? (MT + c.b * 256 + (c.dir ? 3 - i : i) * 64) : (c.b * 2048 + (c.dir ? 35 - i : i - 4) * 64); }
template <bool WITH_Q> __device__ __forceinline__ void gla_load(GlaRegs& R, const GlaCtx& c, int i) {
    const int rb = gla_rowbase(c, i);
#pragma unroll
    for (int jj = 0; jj < 8; ++jj) { const int r = 8 * c.w + jj; const size_t g = (size_t)(rb + (c.dir ? 63 - r : r)) * 1024 + c.h * 128;
        R.f[jj] = *(const unsigned*)(c.Fq + g + 2 * c.lane);
        if (WITH_Q) R.q[jj] = *(const unsigned*)(c.Qb + g + 2 * c.lane);
        R.v[jj] = *(const unsigned*)(c.Vb + g + c.vs * 64 + 2 * (c.lane & 31)); }
}
template <bool OUT, bool NEXT_Q> __device__ __forceinline__ void gla_step(GlaRegs& R, const GlaCtx& c, const int i, const int inext, f32x4 (&S)[4], LAS unsigned char* lds) {
    LAS unsigned char* QS = lds + QS_OFF; LAS unsigned char* KS = lds + KS_OFF; LAS unsigned char* KST = lds + KST_OFF;
    LAS unsigned char* VT = lds + VT_OFF; LAS unsigned char* SPT = lds + SPT_OFF; LAS float* TOT = (LAS float*)(lds + TOT_OFF);
    const int w = c.w, lane = c.lane, fr = c.fr, fq = c.fq, ci = w & 3, vh = w >> 2;
    constexpr bool has_out = OUT;
    float f0[8], f1[8], p0[8], p1[8]; float run0 = 1.f, run1 = 1.f;
#pragma unroll
    for (int jj = 0; jj < 8; ++jj) { f0[jj] = (float)(R.f[jj] & 0xffffu) * (1.f / 65535.f); f1[jj] = (float)(R.f[jj] >> 16) * (1.f / 65535.f);
        run0 *= f0[jj]; run1 *= f1[jj]; p0[jj] = run0; p1[jj] = run1; }
    *(LAS f32x2*)(TOT + w * 128 + 2 * lane) = (f32x2){run0, run1};
    __syncthreads();
    float pre0 = 1.f, pre1 = 1.f, mid0 = 1.f, mid1 = 1.f;
#pragma unroll
    for (int j = 0; j < 8; ++j) { const f32x2 t = *(const LAS f32x2*)(TOT + j * 128 + 2 * lane);
        pre0 *= (j < w) ? t.x : 1.f; pre1 *= (j < w) ? t.y : 1.f; if (j < 4) { mid0 *= t.x; mid1 *= t.y; } }
    const float rmid0 = fast_rcp(mid0), rmid1 = fast_rcp(mid1);
    unsigned kt0[4], kt1[4];
#pragma unroll
    for (int jj = 0; jj < 8; jj += 2) {
        float ka[2], kb[2];
#pragma unroll
        for (int e = 0; e < 2; ++e) { const int j2 = jj + e;
            const float pc0 = p0[j2] * pre0, pc1 = p1[j2] * pre1;
            const float ks0 = (1.f - f0[j2]) * mid0 * fast_rcp(pc0), ks1 = (1.f - f1[j2]) * mid1 * fast_rcp(pc1);
            ka[e] = ks0; kb[e] = ks1;
            if (has_out) {
                *(LAS unsigned*)(KS + (8 * w + j2) * 272 + 4 * lane) = pk2(ks0, ks1);
                const float qs0 = bflo(R.q[j2]) * pc0 * rmid0, qs1 = bfhi(R.q[j2]) * pc1 * rmid1;
                *(LAS unsigned*)(QS + (8 * w + j2) * 272 + 4 * lane) = pk2(qs0, qs1); } }
        kt0[jj >> 1] = pk2(ka[0], ka[1]); kt1[jj >> 1] = pk2(kb[0], kb[1]); }
    *(LAS v4u*)(KST + (2 * lane) * 144 + 16 * w) = (v4u){kt0[0], kt0[1], kt0[2], kt0[3]};
    *(LAS v4u*)(KST + (2 * lane + 1) * 144 + 16 * w) = (v4u){kt1[0], kt1[1], kt1[2], kt1[3]};
    if (lane < 32) {
        *(LAS v4u*)(VT + (2 * lane) * 144 + 16 * w) = (v4u){__builtin_amdgcn_perm(R.v[1], R.v[0], 0x05040100u), __builtin_amdgcn_perm(R.v[3], R.v[2], 0x05040100u), __builtin_amdgcn_perm(R.v[5], R.v[4], 0x05040100u), __builtin_amdgcn_perm(R.v[7], R.v[6], 0x05040100u)};
        *(LAS v4u*)(VT + (2 * lane + 1) * 144 + 16 * w) = (v4u){__builtin_amdgcn_perm(R.v[1], R.v[0], 0x07060302u), __builtin_amdgcn_perm(R.v[3], R.v[2], 0x07060302u), __builtin_amdgcn_perm(R.v[5], R.v[4], 0x07060302u), __builtin_amdgcn_perm(R.v[7], R.v[6], 0x07060302u)}; }
    f32x4 pm4 = (f32x4){1.f, 1.f, 1.f, 1.f}, pl4 = pm4;
#pragma unroll
    for (int j = 0; j < 8; ++j) { const f32x4 t = *(const LAS f32x4*)(TOT + j * 128 + 16 * w + 4 * fq); pl4 *= t; if (j < 4) pm4 *= t; }
    if (has_out) {
#pragma unroll
        for (int vb = 0; vb < 4; ++vb) { const f32x4 sp = pm4 * S[vb];
            *(LAS v2u*)(SPT + (16 * vb + fr) * 272 + (16 * w + 4 * fq) * 2) = (v2u){pk2(sp[0], sp[1]), pk2(sp[2], sp[3])}; } }
    gla_load<NEXT_Q>(R, c, inext);
    __syncthreads();
    if (has_out) {
        bf16x8 qf[4];
#pragma unroll
        for (int kk = 0; kk < 4; ++kk) qf[kk] = *(const LAS bf16x8*)(QS + (16 * ci + fr) * 272 + (32 * kk + 8 * fq) * 2);
        f32x4 at[4];
#pragma unroll
        for (int sb = 0; sb < 4; ++sb) { at[sb] = (f32x4){0.f, 0.f, 0.f, 0.f};
            if (sb <= ci) {
#pragma unroll
                for (int kk = 0; kk < 4; ++kk) { const bf16x8 kf = *(const LAS bf16x8*)(KS + (16 * sb + fr) * 272 + (32 * kk + 8 * fq) * 2); at[sb] = mfma16(kf, qf[kk], at[sb]); }
                if (sb == ci) {
#pragma unroll
                    for (int jj = 0; jj < 4; ++jj) at[sb][jj] = (4 * fq + jj <= fr) ? at[sb][jj] : 0.f; } } }
        f32x4 oacc[2]; oacc[0] = (f32x4){0.f, 0.f, 0.f, 0.f}; oacc[1] = oacc[0];
#pragma unroll
        for (int k2 = 0; k2 < 2; ++k2) {
            if (2 * k2 <= ci) {
                const bf16x8 pb = as_bf16x8((v4u){pk2(at[2 * k2][0], at[2 * k2][1]), pk2(at[2 * k2][2], at[2 * k2][3]), pk2(at[2 * k2 + 1][0], at[2 * k2 + 1][1]), pk2(at[2 * k2 + 1][2], at[2 * k2 + 1][3])});
#pragma unroll
                for (int vt = 0; vt < 2; ++vt) { const LAS unsigned char* vp = VT + (16 * (2 * vh + vt) + fr) * 144 + (32 * k2 + 4 * fq) * 2;
                    const v2u lo = *(const LAS v2u*)vp, hi = *(const LAS v2u*)(vp + 32);
                    oacc[vt] = mfma16(as_bf16x8((v4u){lo[0], lo[1], hi[0], hi[1]}), pb, oacc[vt]); } } }
#pragma unroll
        for (int kk = 0; kk < 4; ++kk)
#pragma unroll
            for (int vt = 0; vt < 2; ++vt) { const bf16x8 sf = *(const LAS bf16x8*)(SPT + (16 * (2 * vh + vt) + fr) * 272 + (32 * kk + 8 * fq) * 2); oacc[vt] = mfma16(sf, qf[kk], oacc[vt]); }
        const int r = 16 * ci + fr; const size_t go = (size_t)(gla_rowbase(c, i) + (c.dir ? 63 - r : r)) * 1024 + c.h * 128 + c.vs * 64 + 4 * fq;
#pragma unroll
        for (int vt = 0; vt < 2; ++vt) *(v2u*)(c.O + go + 16 * (2 * vh + vt)) = (v2u){pk2(oacc[vt][0], oacc[vt][1]), pk2(oacc[vt][2], oacc[vt][3])};
    }
    {
        bf16x8 ka[2];
#pragma unroll
        for (int ss = 0; ss < 2; ++ss) ka[ss] = *(const LAS bf16x8*)(KST + (16 * w + fr) * 144 + (32 * ss + 8 * fq) * 2);
        f32x4 sc;
#pragma unroll
        for (int e = 0; e < 4; ++e) sc[e] = pl4[e] * fast_rcp(pm4[e]);
#pragma unroll
        for (int vb = 0; vb < 4; ++vb) { f32x4 uu = (f32x4){0.f, 0.f, 0.f, 0.f};
#pragma unroll
            for (int ss = 0; ss < 2; ++ss) { const bf16x8 vf = *(const LAS bf16x8*)(VT + (16 * vb + fr) * 144 + (32 * ss + 8 * fq) * 2); uu = mfma16(ka[ss], vf, uu); }
            S[vb] = pl4 * S[vb] + sc * uu; }
    }
}
__device__ __forceinline__ void phase_gla(const Args& a, LAS unsigned char* lds, const int wave_s, const Grp gp) {
    int tid_ = wave_s * 64 + (int)__builtin_amdgcn_mbcnt_hi(~0u, __builtin_amdgcn_mbcnt_lo(~0u, 0u)); const int tid = tid_, lane = tid & 63, w = __builtin_amdgcn_readfirstlane(tid >> 6);
    unsigned char* ws = KA_WS();
    for (int b = gp.g; b < BATCH; b += gp.ng)
    for (int lu = gp.lb; lu < 32; lu += gp.nblk) {
        const int h = lu & 7, dir = (lu >> 3) & 1, vs = lu >> 4;
        GlaCtx c; c.Fq = (const bf16*)(ws + (dir ? WS_FB : WS_FF)); c.Qb = (const bf16*)(ws + WS_Q); c.Vb = (const bf16*)(ws + WS_V);
        c.O = dir ? (bf16*)(ws + WS_OB) : (bf16*)KA_OUT(); c.b = b; c.h = h; c.dir = dir; c.vs = vs; c.w = w; c.lane = lane; c.fr = lane & 15; c.fq = lane >> 4;
        f32x4 S[4];
#pragma unroll
        for (int i = 0; i < 4; ++i) S[i] = (f32x4){0.f, 0.f, 0.f, 0.f};
        GlaRegs RA, RB;
        gla_load<false>(RA, c, 0); gla_load<false>(RB, c, 1);
        gla_step<false, false>(RA, c, 0, 2, S, lds); gla_step<false, false>(RB, c, 1, 3, S, lds);
        gla_step<false, true>(RA, c, 2, 4, S, lds); gla_step<false, true>(RB, c, 3, 5, S, lds);
        for (int i = 4; i < 36; i += 2) { gla_step<true, true>(RA, c, i, min(i + 2, 35), S, lds); gla_step<true, true>(RB, c, i + 1, min(i + 3, 35), S, lds); }
        __syncthreads();
    }
}

__device__ __forceinline__ void phase_pool_grp(LAS unsigned char* lds, const int wave_s, const Grp gp) {
    int tid_ = wave_s * 64 + (int)__builtin_amdgcn_mbcnt_hi(~0u, __builtin_amdgcn_mbcnt_lo(~0u, 0u)); const int tid = tid_, lane = tid & 63, w = wave_s, fr = lane & 15, fq = lane >> 4;
    unsigned char* ws = KA_WS();
    const bf16* Ub = (const bf16*)(ws + WS_U); const bf16* ZP = (const bf16*)(ws + WS_ZP); const bf16* WG = (const bf16*)(ws + WS_WGT); bf16* A4 = (bf16*)(ws + WS_A4);
    const float* scale = KA_IN(13);
    LAS unsigned char* P = lds + 65536;
    v4u pre[4]; bf16x8 bfr[2][8]; int gcur = -1;
    const int upb = (128 - gp.lb + gp.nblk - 1) / gp.nblk;
    const int nun = upb * ((BATCH - gp.g + gp.ng - 1) / gp.ng);
#define POOL_UNIT(k) (((gp.g + ((k) / upb) * gp.ng) * 32) * 4 + gp.lb + ((k) % upb) * gp.nblk)
    int kun = 0, buf = 0;
#define POOL_LOAD(un) do { const bf16* U_ = Ub + (size_t)((un) >> 2) * 64 * 1024 + ((un) & 3) * 256; \
        _Pragma("unroll") for (int i = 0; i < 4; ++i) { const int idx = tid + 512 * i; pre[i] = *(const v4u*)(U_ + (size_t)(idx >> 5) * 1024 + 8 * (idx & 31)); } } while (0)
    if (kun < nun) POOL_LOAD(POOL_UNIT(kun));
    for (; kun < nun; ++kun, buf ^= 1) { const int unit = POOL_UNIT(kun);
        LAS unsigned char* T = lds + buf * 32768;
#pragma unroll
        for (int i = 0; i < 4; ++i) { const int idx = tid + 512 * i; *(LAS v4u*)(T + (idx >> 5) * 512 + 16 * (idx & 31)) = pre[i]; }
        __syncthreads();
        if (kun + 1 < nun) POOL_LOAD(POOL_UNIT(kun + 1));
        const int g = unit & 3, br = unit >> 2;
        if (g != gcur) { gcur = g;
#pragma unroll
            for (int nt = 0; nt < 2; ++nt)
#pragma unroll
                for (int kk = 0; kk < 8; ++kk) { const int ncol = 32 * w + 8 * (fr >> 2) + 4 * nt + (fr & 3);
                    bfr[nt][kk] = *(const bf16x8*)(WG + (size_t)(g * 256 + ncol) * 256 + 32 * kk + 8 * fq); } }
        const int colb = g * 256 + 32 * w + 8 * fq;
        v4u zz[4];
#pragma unroll
        for (int mt = 0; mt < 4; ++mt) zz[mt] = *(const v4u*)(ZP + (size_t)(br * 64 + 16 * mt + fr) * 1024 + colb);
        {
            const int cp = tid & 127, t0 = (tid >> 7) * 16, hw = 1 << g;
            int lo = max(t0 - hw, 0), hi = min(t0 + hw, 64); f32x2 s = (f32x2){0.f, 0.f};
            for (int j = lo; j < hi; ++j) { const unsigned d = *(const LAS unsigned*)(T + j * 512 + 4 * cp); s.x += bflo(d); s.y += bfhi(d); }
#pragma unroll 4
            for (int t = t0; t < t0 + 16; ++t) {
                if (t > t0) { const int nlo = max(t - hw, 0), nhi = min(t + hw, 64);
                    if (nhi > hi) { const unsigned d = *(const LAS unsigned*)(T + (nhi - 1) * 512 + 4 * cp); s.x += bflo(d); s.y += bfhi(d); }
                    if (nlo > lo) { const unsigned d = *(const LAS unsigned*)(T + lo * 512 + 4 * cp); s.x -= bflo(d); s.y -= bfhi(d); }
                    lo = nlo; hi = nhi; }
                const float inv = fast_rcp((float)(hi - lo)); const unsigned ctr = *(const LAS unsigned*)(T + t * 512 + 4 * cp);
                *(LAS unsigned*)(P + t * 528 + 4 * cp) = pk2(s.x * inv - bflo(ctr), s.y * inv - bfhi(ctr));
            }
        }
        __syncthreads();
        f32x4 acc[4][2];
#pragma unroll
        for (int mt = 0; mt < 4; ++mt) { acc[mt][0] = (f32x4){0.f, 0.f, 0.f, 0.f}; acc[mt][1] = acc[mt][0]; }
#pragma unroll
        for (int kk = 0; kk < 8; ++kk)
#pragma unroll
            for (int mt = 0; mt < 4; ++mt) { const bf16x8 afr = *(const LAS bf16x8*)(P + (16 * mt + fr) * 528 + (32 * kk + 8 * fq) * 2);
                acc[mt][0] = mfma16(bfr[0][kk], afr, acc[mt][0]); acc[mt][1] = mfma16(bfr[1][kk], afr, acc[mt][1]); }
        const f32x4 sc0 = *(const f32x4*)(scale + colb), sc1 = *(const f32x4*)(scale + colb + 4);
#pragma unroll
        for (int mt = 0; mt < 4; ++mt) { const size_t o = (size_t)(br * 64 + 16 * mt + fr) * 1024 + colb;
            const f32x4 v0 = acc[mt][0] * sc0, v1 = acc[mt][1] * sc1;
            *(v4u*)(A4 + o) = (v4u){pk2(v0[0] * bflo(zz[mt][0]), v0[1] * bfhi(zz[mt][0])), pk2(v0[2] * bflo(zz[mt][1]), v0[3] * bfhi(zz[mt][1])),
                                     pk2(v1[0] * bflo(zz[mt][2]), v1[1] * bfhi(zz[mt][2])), pk2(v1[2] * bflo(zz[mt][3]), v1[3] * bfhi(zz[mt][3]))}; }
    }
    __syncthreads();
#undef POOL_LOAD
#undef POOL_UNIT
}

struct InProjOrder {
    pg8::StaticOrder lat;
    __device__ __forceinline__ bool next(int i, pg8::Unit& u) const {
        if (lat.next(i, u)) return true;
        const long t = (long)i * lat.G + lat.c - lat.nwg;
        if (t >= 96) return false;
        u.pm = 64 + (int)(t & 7); u.pn = (int)(t >> 3); return true;
    }
    __device__ __forceinline__ void a_ready(const pg8::Unit&) const {}
    __device__ __forceinline__ void done(const pg8::Unit&) const {}
};

__global__ void __launch_bounds__(512, 2) mega_fwd(Args a) {
    extern __shared__ __attribute__((aligned(16))) unsigned char lds_raw[];
    LAS unsigned char* lds = (LAS unsigned char*)lds_raw;
    const int lo = karg_i32(144), hi = karg_i32(148);
    const int wave_s = __builtin_amdgcn_readfirstlane(threadIdx.x >> 6);
#ifndef PROBE_MASK
#define PROBE_MASK 0
#endif
#define IN(k) (lo <= (k) && (k) < hi)
#define REP(k) for (int rep_ = 0; rep_ < (((PROBE_MASK) >> (k)) & 1) + 1; ++rep_, ((((PROBE_MASK) >> (k)) & 1) && rep_ == 1 ? xcd_barrier((unsigned*)(KA_WS() + WS_BAR), (volatile LAS unsigned*)(lds + LDS_ST_OFF), (wave_s == 0) && (__builtin_amdgcn_mbcnt_hi(~0u, __builtin_amdgcn_mbcnt_lo(~0u, 0u)) == 0u), gridDim.x) : (void)0))
#ifndef SYNC_REPS
#define SYNC_REPS 1
#endif
    volatile LAS unsigned* bar_st = (volatile LAS unsigned*)(lds + LDS_ST_OFF);
    const bool leader = (wave_s == 0) && (__builtin_amdgcn_mbcnt_hi(~0u, __builtin_amdgcn_mbcnt_lo(~0u, 0u)) == 0u);
    const bool grp_ok = (gridDim.x % 8u) == 0u;
    Grp gp; gp.ng = grp_ok ? 8 : 1; gp.g = grp_ok ? (int)(blockIdx.x & 7u) : 0; gp.lb = grp_ok ? (int)(blockIdx.x >> 3) : (int)blockIdx.x; gp.nblk = grp_ok ? (int)(gridDim.x >> 3) : (int)gridDim.x;
    if (leader) { bar_st[0] = 0u; bar_st[1] = 0u; bar_st[2] = 0u; bar_st[3] = 0u; const unsigned x = xb_xcc_id();
        (void)xb_add((unsigned*)(KA_WS() + WS_BAR) + XB_XCNT(x), 1u); (void)xb_add((unsigned*)(KA_WS() + WS_BAR) + (1 + gp.g) * XCD_BAR_WORDS + XB_XCNT(x), 1u); }
    __syncthreads();
    if (lo < -1000) cg::this_grid().sync();
#define SEAM(k) do { if (IN(k) && IN((k) + 1)) for (int sr_ = 0; sr_ < SYNC_REPS; ++sr_) xcd_barrier((unsigned*)(KA_WS() + WS_BAR), bar_st, leader, gridDim.x); } while (0)
#define SEAM_GRP(k) do { if (IN(k) && IN((k) + 1)) { if (grp_ok) xcd_barrier((unsigned*)(KA_WS() + WS_BAR) + (1 + gp.g) * XCD_BAR_WORDS, bar_st + 2, leader, (unsigned)gp.nblk); \
                                                      else xcd_barrier((unsigned*)(KA_WS() + WS_BAR), bar_st, leader, gridDim.x); } } while (0)
    unsigned char* ws = KA_WS();
    if (IN(0)) REP(0) { phase_prologue(a, lds, wave_s); } SEAM(0);
    if (IN(1)) REP(1) { phase_modnorm(a, 0, KA_IN(0), MT, (bf16*)KA_OUT(), wave_s, gp); } SEAM_GRP(1);
    if (IN(2)) REP(2) {
        EpiInProj E{ws, 0};
        pg8::Gemm g{(const bf16*)KA_OUT(), (const bf16*)(ws + WS_W0T), MT, 5120, 1024, 1024, 1024, 0}; InProjOrder S; S.lat.init(MT, 5120, gridDim.x, blockIdx.x);
        pg8::gemm_phase<EpiInProj, InProjOrder>(lds, g, S, E, wave_s);
    } SEAM_GRP(2);
    if (IN(3)) REP(3) { phase_gla(a, lds, wave_s, gp); } SEAM_GRP(3);
    if (IN(4)) REP(4) { phase_headnorm(a, wave_s, gp); } SEAM_GRP(4);
    const bool fuse = (gridDim.x == 256);
    if (IN(5)) REP(5) {
        pg8::Gemm g{(const bf16*)(ws + WS_A1), (const bf16*)(ws + WS_W1T), MT, 1024, 1024, 1024, 1024, 0}; pg8::StaticOrder S; S.init(MT, 1024, gridDim.x, blockIdx.x);
        if (fuse) {
            EpiResidNorm<0> E{KA_IN(0), (void*)(ws + WS_X1), (const float*)(ws + WS_MOD) + 2048, KA_IN(6) + 1024, (const float*)(ws + WS_MOD) + 9 * 3072, (bf16*)(ws + WS_A2),
                              (float*)(ws + WS_PART), (unsigned*)(ws + WS_BAR) + BAR_CNT_WORD0, (unsigned*)(ws + WS_BAR)};
            pg8::gemm_phase<EpiResidNorm<0>, pg8::StaticOrder>(lds, g, S, E, wave_s);
        } else {
            EpiResid E{KA_IN(0), (float*)(ws + WS_X1), (const float*)(ws + WS_MOD) + 2048};
            pg8::gemm_phase<EpiResid, pg8::StaticOrder>(lds, g, S, E, wave_s);
        }
    } SEAM_GRP(5);
    if (IN(6) && !fuse) REP(6) { phase_modnorm(a, 1, (const float*)(ws + WS_X1), MT, (bf16*)(ws + WS_A2), wave_s, gp); }
    if (!fuse) SEAM(6);
    if (IN(7)) REP(7) {
        EpiPoolIn E{(bf16*)(ws + WS_U), (bf16*)(ws + WS_ZP)};
        pg8::Gemm g{(const bf16*)(ws + WS_A2), (const bf16*)(ws + WS_W2T), MT, 2048, 1024, 1024, 1024, 0}; pg8::StaticOrder S; S.init(MT, 2048, gridDim.x, blockIdx.x);
        pg8::gemm_phase<EpiPoolIn, pg8::StaticOrder>(lds, g, S, E, wave_s);
    } SEAM_GRP(7);
    if (IN(8)) REP(8) { phase_pool_grp(lds, wave_s, gp); } SEAM_GRP(8);
    if (IN(10)) REP(10) {
        pg8::Gemm g{(const bf16*)(ws + WS_A4), (const bf16*)(ws + WS_W3T), MT, 1024, 1024, 1024, 1024, 0}; pg8::StaticOrder S; S.init(MT, 1024, gridDim.x, blockIdx.x);
        if (fuse) {
            EpiResidNorm<1> E{(const void*)(ws + WS_X1), (void*)KA_OUT(), (const float*)(ws + WS_MOD) + 9 * 3072 + 2048, KA_IN(15), nullptr, nullptr,
                              (float*)(ws + WS_PART) + (size_t)MT * 16, (unsigned*)(ws + WS_BAR) + BAR_CNT_WORD0 + 4096, (unsigned*)(ws + WS_BAR)};
            pg8::gemm_phase<EpiResidNorm<1>, pg8::StaticOrder>(lds, g, S, E, wave_s);
        } else {
            EpiResid E{(const float*)(ws + WS_X1), KA_OUT(), (const float*)(ws + WS_MOD) + 9 * 3072 + 2048};
            pg8::gemm_phase<EpiResid, pg8::StaticOrder>(lds, g, S, E, wave_s);
        }
    }
    if (!fuse) { SEAM(10); if (IN(11)) REP(11) { phase_final(a, wave_s); } }
#undef IN
#undef SEAM
}

extern "C" void kernel_launch(void* const* d_in, const int* in_sizes, int n_in, void* d_out, int out_size, void* d_ws, size_t ws_size, hipStream_t stream) {
    static int grid = 0;
    if (grid == 0) {
        if (n_in != 16 || out_size != MT * D || ws_size < WS_END) { fprintf(stderr, "kernel_launch: unexpected shapes (n_in %d out %d ws %zu)\n", n_in, out_size, ws_size); grid = -1; return; }
        int dev = 0, cus = 0, per_cu = 0;
        (void)hipGetDevice(&dev); (void)hipDeviceGetAttribute(&cus, hipDeviceAttributeMultiprocessorCount, dev);
        if (hipFuncSetAttribute((const void*)mega_fwd, hipFuncAttributeMaxDynamicSharedMemorySize, LDS_BYTES) != hipSuccess) fprintf(stderr, "kernel_launch: hipFuncSetAttribute failed\n");
        if (hipOccupancyMaxActiveBlocksPerMultiprocessor(&per_cu, (const void*)mega_fwd, 512, LDS_BYTES) != hipSuccess || per_cu < 1) { fprintf(stderr, "kernel_launch: occupancy query gave %d\n", per_cu); per_cu = 1; }
        (void)hipGetLastError();
        grid = cus * per_cu;
        fprintf(stderr, "kernel_launch: grid %d (cus %d x %d)\n", grid, cus, per_cu);
    }
    if (grid < 0) return;
    Args a{};
    for (int i = 0; i < 16; ++i) a.in[i] = (const float*)d_in[i];
    a.out = (float*)d_out; a.ws = (unsigned char*)d_ws;
#if MK_N_LAUNCHES == 1
    if (hipMemsetAsync((char*)d_ws + WS_BAR, 0, BAR_BYTES, stream) != hipSuccess) fprintf(stderr, "kernel_launch: memset of barrier words failed\n");
    a.ph_lo = 0; a.ph_hi = NPHASE;
    void* args[] = {&a};
    hipError_t e = hipLaunchCooperativeKernel((const void*)mega_fwd, dim3(grid), dim3(512), args, LDS_BYTES, stream);
    if (e != hipSuccess) fprintf(stderr, "kernel_launch: cooperative launch failed: %s (grid %d)\n", hipGetErrorString(e), grid);
#else
    for (int ph = 0; ph < NPHASE; ++ph) { a.ph_lo = ph; a.ph_hi = ph + 1; hipLaunchKernelGGL(mega_fwd, dim3(grid), dim3(512), LDS_BYTES, stream, a); }
#endif
}
```
